# Optimizing an MI355X kernel written in HIP

```python
import jax, jax.numpy as jnp
from jax import lax
import numpy as np

D_MODEL = 1024
BATCH = 16
SEQ = 256
DEPTH = 4
DEC_BATCH = 2
DEC_SEQ = 2048
PAST_LEN = 256

GRID_W = 64
N_MIXERS = 3
CONV_WIDTH = 3
HEAD_DIM = 128
N_HEADS = D_MODEL // HEAD_DIM
N_KV_HEADS = 2
ROPE_THETA = 10000.0
Q_BLOCK = 128
GLA_HEADS = 4
GLA_DK = (D_MODEL // 2) // GLA_HEADS
GLA_DV = D_MODEL // GLA_HEADS
GLA_GATE_RANK = 16
GLA_TAU = 16.0
GLA_CHUNK = 64
D_FF = -(-8 * D_MODEL // (3 * 256)) * 256
DEEPNORM_ALPHA = (2.0 * DEPTH) ** 0.25
DEEPNORM_BETA = (8.0 * DEPTH) ** -0.25
LN_EPS = 1e-5
RMS_EPS = 1e-6
N_CONV_LAYERS = len(range(0, DEPTH, N_MIXERS))
N_ATTN_LAYERS = len(range(1, DEPTH, N_MIXERS))
N_GLA_LAYERS = len(range(2, DEPTH, N_MIXERS))

kernel_name = "hybrid_diffusion_conv_gqa_gla_step"


def layer_norm(x, g, b):
    xf = x.astype(jnp.float32)
    mu = jnp.mean(xf, axis=-1, keepdims=True)
    var = jnp.mean(jnp.square(xf - mu), axis=-1, keepdims=True)
    return ((xf - mu) * lax.rsqrt(var + LN_EPS) * g + b).astype(x.dtype)


def rms_norm(x, g):
    xf = x.astype(jnp.float32)
    return (xf * lax.rsqrt(jnp.mean(xf * xf, axis=-1, keepdims=True) + RMS_EPS) * g).astype(x.dtype)


def modulation(cond, w, b):
    m = (jax.nn.silu(cond) @ w + b)[:, None, :]
    return jnp.split(m, 6, axis=-1)


def short_conv(h, w_in, w_conv, w_out):
    bg, cg, u = jnp.split(h @ w_in, 3, axis=-1)
    u = cg * u
    up = jnp.pad(u, ((0, 0), (1, 1), (0, 0)))
    y = up[:, :-2] * w_conv[0] + up[:, 1:-1] * w_conv[1] + up[:, 2:] * w_conv[2]
    return (bg * y) @ w_out


def axial_rope_tables(seq):
    rows = seq // GRID_W
    row = jnp.repeat(jnp.arange(rows), GRID_W)
    col = jnp.tile(jnp.arange(GRID_W), rows)
    pos = jnp.stack([row, col], axis=-1).astype(jnp.float32)
    n_freq = HEAD_DIM // 4
    freqs = ROPE_THETA ** (-jnp.arange(n_freq, dtype=jnp.float32) / n_freq)
    ang = pos[:, :, None] * freqs
    return jnp.cos(ang), jnp.sin(ang)


def apply_axial_rope(x, cos, sin):
    B, S, Hh, _ = x.shape
    xr = x.astype(jnp.float32).reshape(B, S, Hh, 2, 2, HEAD_DIM // 4)
    x1, x2 = xr[..., 0, :], xr[..., 1, :]
    cb, sb = cos[None, :, None], sin[None, :, None]
    out = jnp.stack([x1 * cb - x2 * sb, x2 * cb + x1 * sb], axis=-2)
    return out.reshape(B, S, Hh, HEAD_DIM).astype(x.dtype)


def attn_qkv(h, w_qkv, q_g, k_g):
    B, S, _ = h.shape
    q, k, v = jnp.split(h @ w_qkv, [N_HEADS * HEAD_DIM, (N_HEADS + N_KV_HEADS) * HEAD_DIM], axis=-1)
    q = rms_norm(q.reshape(B, S, N_HEADS, HEAD_DIM), q_g)
    k = rms_norm(k.reshape(B, S, N_KV_HEADS, HEAD_DIM), k_g)
    v = v.reshape(B, S, N_KV_HEADS, HEAD_DIM)
    return q, k, v


def blocked_attention(q, k, v):
    B, S, H, hd = q.shape
    KV = k.shape[2]
    G = H // KV
    nb = S // Q_BLOCK
    qb = q.reshape(B, nb, Q_BLOCK, KV, G, hd).transpose(1, 0, 2, 3, 4, 5)
    scale = HEAD_DIM ** -0.5

    def one_block(qblk):
        s = jnp.einsum('bqkgd,btkd->bkgqt', qblk, k).astype(jnp.float32) * scale
        p = jax.nn.softmax(s, axis=-1).astype(v.dtype)
        return jnp.einsum('bkgqt,btkd->bqkgd', p, v)

    o = lax.map(one_block, qb)
    return o.transpose(1, 0, 2, 3, 4, 5).reshape(B, S, H * hd)


def gla_log_gate(h, w1, w2, b):
    B, S, _ = h.shape
    z = ((h @ w1) @ w2 + b).astype(jnp.float32)
    return (jax.nn.log_sigmoid(z) / GLA_TAU).reshape(B, S, GLA_HEADS, GLA_DK)


def gla_chunk_scan(q, k, v, logg, s0):
    B, S, H, _ = q.shape
    L = GLA_CHUNK
    n = S // L

    def to_chunks(a):
        return a.astype(jnp.float32).reshape(B, n, L, H, a.shape[-1]).transpose(1, 0, 3, 2, 4)

    mask = jnp.tril(jnp.ones((L, L), dtype=bool))[:, :, None]

    def step(state, inp):
        qc, kc, vc, gc = inp
        bcum = jnp.cumsum(gc, axis=2)
        o_inter = jnp.einsum('bhld,bhde->bhle', qc * jnp.exp(bcum), state)
        diff = bcum[:, :, :, None, :] - bcum[:, :, None, :, :]
        decay = jnp.where(mask, jnp.exp(jnp.where(mask, diff, 0.0)), 0.0)
        a = jnp.einsum('bhtd,bhsd,bhtsd->bhts', qc, kc, decay)
        o_intra = jnp.einsum('bhts,bhse->bhte', a, vc)
        b_last = bcum[:, :, -1]
        new_state = jnp.exp(b_last)[..., None] * state + jnp.einsum(
            'bhsd,bhse->bhde', kc * jnp.exp(b_last[:, :, None] - bcum), vc)
        return new_state, o_inter + o_intra

    s_fin, o = lax.scan(step, s0.astype(jnp.float32),
                        (to_chunks(q), to_chunks(k), to_chunks(v), to_chunks(logg)))
    o = o.transpose(1, 0, 3, 2, 4).reshape(B, S, H, v.shape[-1])
    return o.astype(v.dtype), s_fin


def gla_mixer(h, s0f, s0b, w_in, w_g1, w_g2, b_g, norm_g, w_o):
    B, S, _ = h.shape
    hk = GLA_HEADS * GLA_DK
    hv = GLA_HEADS * GLA_DV
    q, k, v, og = jnp.split(h @ w_in, [hk, 2 * hk, 2 * hk + hv], axis=-1)
    q = q.reshape(B, S, GLA_HEADS, GLA_DK) * (GLA_DK ** -0.5)
    k = k.reshape(B, S, GLA_HEADS, GLA_DK)
    v = v.reshape(B, S, GLA_HEADS, GLA_DV)
    lg_f = gla_log_gate(h, w_g1[0], w_g2[0], b_g[0])
    lg_b = gla_log_gate(h, w_g1[1], w_g2[1], b_g[1])
    o_f, sf = gla_chunk_scan(q, k, v, lg_f, s0f)
    o_b, sb = gla_chunk_scan(jnp.flip(q, 1), jnp.flip(k, 1), jnp.flip(v, 1), jnp.flip(lg_b, 1), s0b)
    o = o_f + jnp.flip(o_b, 1)
    o = rms_norm(o, norm_g) * jax.nn.silu(og).reshape(B, S, GLA_HEADS, GLA_DV)
    return o.reshape(B, S, hv) @ w_o, sf, sb


def swiglu(h, w_in, w_out):
    g, u = jnp.split(h @ w_in, 2, axis=-1)
    return (jax.nn.silu(g) * u) @ w_out


def setup_inputs(seed: int = 0) -> dict:
    key = jax.random.key(seed)
    ks = jax.random.split(key, 32)
    f32 = jnp.float32
    D = D_MODEL

    def nrm(k, shape, scale=1.0):
        return jax.random.normal(k, shape, f32) * scale

    qkv_out = (N_HEADS + 2 * N_KV_HEADS) * HEAD_DIM
    gla_in = 2 * GLA_HEADS * GLA_DK + 2 * GLA_HEADS * GLA_DV
    return {
        "x_prompt": nrm(ks[0], (BATCH, SEQ, D)),
        "x_sample": nrm(ks[1], (DEC_BATCH, DEC_SEQ, D)),
        "c": nrm(ks[2], (DEC_BATCH, D)),
        "cache_k": nrm(ks[3], (DEC_BATCH, N_ATTN_LAYERS, PAST_LEN, N_KV_HEADS, HEAD_DIM)),
        "cache_v": nrm(ks[4], (DEC_BATCH, N_ATTN_LAYERS, PAST_LEN, N_KV_HEADS, HEAD_DIM)),
        "state_gla_fwd": nrm(ks[5], (DEC_BATCH, N_GLA_LAYERS, GLA_HEADS, GLA_DK, GLA_DV), 0.5),
        "state_gla_bwd": nrm(ks[6], (DEC_BATCH, N_GLA_LAYERS, GLA_HEADS, GLA_DK, GLA_DV), 0.5),
        "c_ctx": nrm(ks[7], (D,)),
        "w_ada": nrm(ks[8], (DEPTH, D, 6 * D), 0.5 * D ** -0.5),
        "b_ada": nrm(ks[9], (DEPTH, 6 * D), 0.02),
        "ln_g": 1.0 + nrm(ks[10], (DEPTH, 2, D), 0.02),
        "ln_b": nrm(ks[11], (DEPTH, 2, D), 0.02),
        "conv_w_in": nrm(ks[12], (N_CONV_LAYERS, D, 3 * D), D ** -0.5),
        "conv_w": nrm(ks[13], (N_CONV_LAYERS, CONV_WIDTH, D), CONV_WIDTH ** -0.5),
        "conv_w_out": nrm(ks[14], (N_CONV_LAYERS, D, D), DEEPNORM_BETA * D ** -0.5),
        "attn_w_qkv": nrm(ks[15], (N_ATTN_LAYERS, D, qkv_out), D ** -0.5),
        "attn_q_norm": 1.0 + nrm(ks[16], (N_ATTN_LAYERS, HEAD_DIM), 0.02),
        "attn_k_norm": 1.0 + nrm(ks[17], (N_ATTN_LAYERS, HEAD_DIM), 0.02),
        "attn_w_o": nrm(ks[18], (N_ATTN_LAYERS, N_HEADS * HEAD_DIM, D), DEEPNORM_BETA * (N_HEADS * HEAD_DIM) ** -0.5),
        "gla_w_in": nrm(ks[19], (N_GLA_LAYERS, D, gla_in), D ** -0.5),
        "gla_w_gate1": nrm(ks[20], (N_GLA_LAYERS, 2, D, GLA_GATE_RANK), D ** -0.5),
        "gla_w_gate2": nrm(ks[21], (N_GLA_LAYERS, 2, GLA_GATE_RANK, GLA_HEADS * GLA_DK), GLA_GATE_RANK ** -0.5),
        "gla_b_gate": nrm(ks[22], (N_GLA_LAYERS, 2, GLA_HEADS * GLA_DK), 0.02),
        "gla_norm": 1.0 + nrm(ks[23], (N_GLA_LAYERS, GLA_DV), 0.02),
        "gla_w_o": nrm(ks[24], (N_GLA_LAYERS, GLA_HEADS * GLA_DV, D), DEEPNORM_BETA * (GLA_HEADS * GLA_DV) ** -0.5),
        "ffn_w_in": nrm(ks[25], (DEPTH, D, 2 * D_FF), D ** -0.5),
        "ffn_w_out": nrm(ks[26], (DEPTH, D_FF, D), DEEPNORM_BETA * D_FF ** -0.5),
    }


def reference(x_prompt, x_sample, c, cache_k, cache_v, state_gla_fwd, state_gla_bwd, c_ctx,
              w_ada, b_ada, ln_g, ln_b, conv_w_in, conv_w, conv_w_out,
              attn_w_qkv, attn_q_norm, attn_k_norm, attn_w_o,
              gla_w_in, gla_w_gate1, gla_w_gate2, gla_b_gate, gla_norm, gla_w_o,
              ffn_w_in, ffn_w_out):
    xp = x_prompt
    xs = x_sample
    cos, sin = axial_rope_tables(xs.shape[1])
    cond_ctx = c_ctx[None, :]
    new_k, new_v, new_sf, new_sb = [], [], [], []
    for i in range(DEPTH):
        kind = i % N_MIXERS
        j = i // N_MIXERS
        sh_p, sc_p, ga_p, sh2_p, sc2_p, ga2_p = modulation(cond_ctx, w_ada[i], b_ada[i])
        sh_s, sc_s, ga_s, sh2_s, sc2_s, ga2_s = modulation(c, w_ada[i], b_ada[i])
        hp = xp * (1.0 + sc_p) + sh_p
        hs = xs * (1.0 + sc_s) + sh_s
        if kind == 0:
            mix_p = short_conv(hp, conv_w_in[j], conv_w[j], conv_w_out[j])
            mix_s = short_conv(hs, conv_w_in[j], conv_w[j], conv_w_out[j])
        elif kind == 1:
            qp, kp, vp = attn_qkv(hp, attn_w_qkv[j], attn_q_norm[j], attn_k_norm[j])
            mix_p = blocked_attention(qp, kp, vp) @ attn_w_o[j]
            new_k.append(kp)
            new_v.append(vp)
            qs, ks_, vs = attn_qkv(hs, attn_w_qkv[j], attn_q_norm[j], attn_k_norm[j])
            qs = apply_axial_rope(qs, cos, sin)
            ks_ = apply_axial_rope(ks_, cos, sin)
            k_all = jnp.concatenate([cache_k[:, j].astype(ks_.dtype), ks_], axis=1)
            v_all = jnp.concatenate([cache_v[:, j].astype(vs.dtype), vs], axis=1)
            mix_s = blocked_attention(qs, k_all, v_all) @ attn_w_o[j]
        else:
            zeros = jnp.zeros((xp.shape[0], GLA_HEADS, GLA_DK, GLA_DV), jnp.float32)
            mix_p, sf, sb = gla_mixer(hp, zeros, zeros, gla_w_in[j], gla_w_gate1[j], gla_w_gate2[j],
                                      gla_b_gate[j], gla_norm[j], gla_w_o[j])
            new_sf.append(sf)
            new_sb.append(sb)
            mix_s, _, _ = gla_mixer(hs, state_gla_fwd[:, j], state_gla_bwd[:, j], gla_w_in[j],
                                    gla_w_gate1[j], gla_w_gate2[j], gla_b_gate[j], gla_norm[j], gla_w_o[j])
        xp = layer_norm(DEEPNORM_ALPHA * xp + ga_p * mix_p, ln_g[i, 0], ln_b[i, 0])
        xs = layer_norm(DEEPNORM_ALPHA * xs + ga_s * mix_s, ln_g[i, 0], ln_b[i, 0])
        hp = xp * (1.0 + sc2_p) + sh2_p
        hs = xs * (1.0 + sc2_s) + sh2_s
        xp = layer_norm(DEEPNORM_ALPHA * xp + ga2_p * swiglu(hp, ffn_w_in[i], ffn_w_out[i]), ln_g[i, 1], ln_b[i, 1])
        xs = layer_norm(DEEPNORM_ALPHA * xs + ga2_s * swiglu(hs, ffn_w_in[i], ffn_w_out[i]), ln_g[i, 1], ln_b[i, 1])
    new_cache_k = jnp.stack(new_k, axis=1)
    new_cache_v = jnp.stack(new_v, axis=1)
    new_state_fwd = jnp.stack(new_sf, axis=1)
    new_state_bwd = jnp.stack(new_sb, axis=1)
    return (xp, xs, new_cache_k, new_cache_v, new_state_fwd, new_state_bwd)
```

```cpp
#include <hip/hip_runtime.h>
#include <hip/hip_cooperative_groups.h>
#include <cstdio>
#include <cstdint>
namespace cg = cooperative_groups;

typedef unsigned short bf16_t;
typedef short bf16x8 __attribute__((ext_vector_type(8)));
typedef float f32x4 __attribute__((ext_vector_type(4)));
typedef unsigned u32x4 __attribute__((ext_vector_type(4)));
typedef unsigned u32x2 __attribute__((ext_vector_type(2)));
#define DEVI __device__ __forceinline__

constexpr int D = 1024, MTOK = 8192, MP = 4096, DFF = 2816;
constexpr float ALPHA = 1.6817928305074290f;
constexpr int NTHREADS = 512;
constexpr int LDS_BYTES = 139264;

constexpr size_t WS_WCIN  = 0;
constexpr size_t WS_WCOUT = WS_WCIN  + 2ull * 3072 * 1024 * 2;
constexpr size_t WS_WQKV  = WS_WCOUT + 2ull * 1024 * 1024 * 2;
constexpr size_t WS_WAO   = WS_WQKV  + 1536ull * 1024 * 2;
constexpr size_t WS_WGIN  = WS_WAO   + 1024ull * 1024 * 2;
constexpr size_t WS_WGO   = WS_WGIN  + 3328ull * 1024 * 2;
constexpr size_t WS_WFIN  = WS_WGO   + 1024ull * 1024 * 2;
constexpr size_t WS_WFOUT = WS_WFIN  + 4ull * 5632 * 1024 * 2;
constexpr size_t WS_MODP  = WS_WFOUT + 4ull * 1024 * 2816 * 2;
constexpr size_t WS_MOD   = WS_MODP  + 16ull * 4 * 3 * 6144 * 4;
constexpr size_t WS_X     = WS_MOD   + 4ull * 3 * 6144 * 4;
constexpr size_t WS_H     = WS_X     + 8192ull * 1024 * 4;
constexpr size_t WS_BIG   = WS_H     + 8192ull * 1024 * 2;
constexpr size_t WS_Z     = WS_BIG   + 8192ull * 3328 * 2;
constexpr size_t WS_GQ    = WS_Z     + 8192ull * 1024 * 2;
constexpr size_t WS_GA    = WS_GQ    + 2ull * 8192 * 512 * 2;
constexpr size_t WS_GG    = WS_GA    + 512ull * 64 * 64 * 2;
constexpr size_t WS_GU    = WS_GG    + 1024ull * 128 * 4;
constexpr size_t WS_END   = WS_GU    + 1024ull * 256 * 128 * 2;
constexpr size_t WS_GVT   = WS_H;
constexpr size_t WS_AQ    = WS_BIG + 8192ull * 1536 * 2;
constexpr size_t WS_AKP   = WS_AQ  + 8192ull * 1024 * 2;
constexpr size_t WS_AKS   = WS_AKP + 16ull * 256 * 256 * 2;
constexpr size_t WS_AVP   = WS_AKS + 2ull * 2304 * 256 * 2;
constexpr size_t WS_AVS   = WS_AVP + 16ull * 2 * 128 * 256 * 2;
static_assert(WS_AVS + 2ull * 2 * 128 * 2304 * 2 <= WS_Z, "attention buffers overflow BIG");

constexpr size_t OUT_Y = 0, OUT_CK = 8388608, OUT_CV = 9437184, OUT_SF = 10485760, OUT_SB = 12582912;

struct Params {
    const float* in[27];
    float* out;
    unsigned char* ws;
};
__device__ __forceinline__ int otid() { int t = threadIdx.x; asm volatile("" : "+v"(t)); return t; }
__device__ __forceinline__ int obid() { int b = blockIdx.x; asm volatile("" : "+s"(b)); return b; }
__device__ __forceinline__ const float* inp(int i) {
    const float* const* ka = (const float* const*)__builtin_amdgcn_kernarg_segment_ptr();
    asm volatile("" : "+s"(i));
    return ka[i];
}

typedef float f32x2_t __attribute__((ext_vector_type(2)));
typedef __bf16 bf16x2_t __attribute__((ext_vector_type(2)));
DEVI unsigned pk2(float lo, float hi) { f32x2_t v = {lo, hi}; bf16x2_t b = __builtin_convertvector(v, bf16x2_t); return __builtin_bit_cast(unsigned, b); }
DEVI float bflo(unsigned u) { return __uint_as_float(u << 16); }
DEVI float bfhi(unsigned u) { return __uint_as_float(u & 0xffff0000u); }
DEVI float bf2f(bf16_t u) { return __uint_as_float(((unsigned)u) << 16); }
DEVI float silu_f(float x) { return x * __builtin_amdgcn_rcpf(1.f + __expf(-x)); }
DEVI float wave_sum(float v) {
#pragma unroll
    for (int o = 1; o < 64; o <<= 1) v += __shfl_xor(v, o);
    return v;
}
DEVI int row_cond(int row) { return row < MP ? 0 : 1 + ((row - MP) >> 11); }

struct TJob { int in_idx, src_off, K, N, map, row_off, dst_ld; unsigned dst_off; };
__device__ const TJob g_jobs[18] = {
    {12, 0,               1024, 3072, 0, 0, 1024, (unsigned)WS_WCIN},
    {12, 1024 * 3072,     1024, 3072, 0, 0, 1024, (unsigned)(WS_WCIN + 3072ull * 1024 * 2)},
    {14, 0,               1024, 1024, 0, 0, 1024, (unsigned)WS_WCOUT},
    {14, 1024 * 1024,     1024, 1024, 0, 0, 1024, (unsigned)(WS_WCOUT + 1024ull * 1024 * 2)},
    {15, 0,               1024, 1536, 0, 0, 1024, (unsigned)WS_WQKV},
    {18, 0,               1024, 1024, 0, 0, 1024, (unsigned)WS_WAO},
    {19, 0,               1024, 3072, 0, 0, 1024, (unsigned)WS_WGIN},
    {20, 0,               1024, 16,   0, 3072, 1024, (unsigned)WS_WGIN},
    {20, 1024 * 16,       1024, 16,   0, 3088, 1024, (unsigned)WS_WGIN},
    {24, 0,               1024, 1024, 0, 0, 1024, (unsigned)WS_WGO},
    {25, 0,               1024, 5632, 1, 0, 1024, (unsigned)WS_WFIN},
    {25, 1024 * 5632,     1024, 5632, 1, 0, 1024, (unsigned)(WS_WFIN + 1ull * 5632 * 1024 * 2)},
    {25, 2 * 1024 * 5632, 1024, 5632, 1, 0, 1024, (unsigned)(WS_WFIN + 2ull * 5632 * 1024 * 2)},
    {25, 3 * 1024 * 5632, 1024, 5632, 1, 0, 1024, (unsigned)(WS_WFIN + 3ull * 5632 * 1024 * 2)},
    {26, 0,               2816, 1024, 0, 0, 2816, (unsigned)WS_WFOUT},
    {26, 2816 * 1024,     2816, 1024, 0, 0, 2816, (unsigned)(WS_WFOUT + 1ull * 1024 * 2816 * 2)},
    {26, 2 * 2816 * 1024, 2816, 1024, 0, 0, 2816, (unsigned)(WS_WFOUT + 2ull * 1024 * 2816 * 2)},
    {26, 3 * 2816 * 1024, 2816, 1024, 0, 0, 2816, (unsigned)(WS_WFOUT + 3ull * 1024 * 2816 * 2)},
};
constexpr int N_MODJOBS = 192;

DEVI void transpose_item(const float* W, int K, int N, int map, bf16_t* dst, int dst_ld, int row_off, int item, float* tl) {
    const int nb = (N + 63) >> 6;
    const int kb = item / nb, nbi = item - kb * nb, k0 = kb * 64, n0 = nbi * 64;
    const int tid = otid();
    {
        const int c = tid & 63, r = tid >> 6, n = n0 + c;
#pragma unroll
        for (int i = 0; i < 8; ++i) { const int kk = r + 8 * i; tl[kk * 65 + c] = (n < N) ? W[(size_t)(k0 + kk) * N + n] : 0.f; }
    }
    __syncthreads();
    {
        const int kp = tid & 31, nr = tid >> 5;
#pragma unroll
        for (int i = 0; i < 4; ++i) {
            const int nl = nr + 16 * i, n = n0 + nl;
            if (n < N) {
                int np = n;
                if (map == 1) np = (n < DFF) ? (256 * (n >> 7) + (n & 127)) : (256 * ((n - DFF) >> 7) + 128 + ((n - DFF) & 127));
                const float a = tl[(2 * kp) * 65 + nl], b = tl[(2 * kp + 1) * 65 + nl];
                *(unsigned*)(dst + (size_t)(row_off + np) * dst_ld + k0 + 2 * kp) = pk2(a, b);
            }
        }
    }
    __syncthreads();
}

DEVI void mod_job(const Params& p, int job, float* sl) {
    const int third = job % 3, lk = job / 3, kc = lk & 15, l = lk >> 4;
    const int tid = otid();
    if (tid < 192) {
        const int c = tid >> 6, kk = tid & 63, k = kc * 64 + kk;
        const float x = (c == 0) ? inp(7)[k] : inp(2)[(c - 1) * 1024 + k];
        sl[c * 64 + kk] = silu_f(x);
    }
    __syncthreads();
    const int n0 = third * 2048 + tid * 4;
    const float* W = inp(8) + (size_t)l * 1024 * 6144 + (size_t)(kc * 64) * 6144 + n0;
    f32x4 a0 = {0, 0, 0, 0}, a1 = a0, a2 = a0;
#pragma unroll 8
    for (int kk = 0; kk < 64; ++kk) {
        const f32x4 w = *(const f32x4*)(W + (size_t)kk * 6144);
        a0 += w * sl[kk]; a1 += w * sl[64 + kk]; a2 += w * sl[128 + kk];
    }
    float* P = (float*)(p.ws + WS_MODP) + (size_t)((kc * 4 + l) * 3) * 6144 + n0;
    *(f32x4*)(P) = a0; *(f32x4*)(P + 6144) = a1; *(f32x4*)(P + 2 * 6144) = a2;
    __syncthreads();
}

DEVI void phase_prep(const Params& p, unsigned char* smem) {
    float* tl = (float*)smem;
    int total = N_MODJOBS;
    int jstart[19];
#pragma unroll
    for (int j = 0; j < 18; ++j) { jstart[j] = total; total += (g_jobs[j].K >> 6) * ((g_jobs[j].N + 63) >> 6); }
    jstart[18] = total;
    for (int it = obid(); it < total; it += gridDim.x) {
        if (it < N_MODJOBS) { mod_job(p, it, tl); continue; }
        int j = 0;
#pragma unroll
        for (int q = 1; q < 18; ++q) if (it >= jstart[q]) j = q;
        const TJob jb = g_jobs[j];
        transpose_item(inp(__builtin_amdgcn_readfirstlane(jb.in_idx)) + jb.src_off, jb.K, jb.N, jb.map, (bf16_t*)(p.ws + jb.dst_off), jb.dst_ld, jb.row_off, it - jstart[j], tl);
    }
    {
        u32x4* z = (u32x4*)(p.ws + WS_WGIN + 3104ull * 1024 * 2);
        const int n16 = 224 * 1024 * 2 / 16;
        for (int i = obid() * NTHREADS + otid(); i < n16; i += gridDim.x * NTHREADS) z[i] = (u32x4){0, 0, 0, 0};
    }
}

DEVI void phase_modfinal(const Params& p) {
    const float* P = (const float*)(p.ws + WS_MODP);
    float* Mo = (float*)(p.ws + WS_MOD);
    for (int idx = obid() * NTHREADS + otid(); idx < 4 * 3 * 6144; idx += gridDim.x * NTHREADS) {
        const int l = idx / 18432, rem = idx - l * 18432, c = rem / 6144, j = rem - c * 6144;
        float s = inp(9)[l * 6144 + j];
#pragma unroll
        for (int kc = 0; kc < 16; ++kc) s += P[(size_t)((kc * 4 + l) * 3 + c) * 6144 + j];
        Mo[idx] = s;
    }
}

template <int MODE>
DEVI void phase_rows(const Params& p, const float* lng, const float* lnb, const float* modn, int ch_sh, int ch_sc, bool write_out) {
    float* X = (float*)(p.ws + WS_X);
    bf16_t* H = (bf16_t*)(p.ws + WS_H);
    const int lane = otid() & 63;
    const int gw = obid() * 8 + (otid() >> 6), NW = gridDim.x * 8;
    for (int row = gw; row < MTOK; row += NW) {
        const float* src = (MODE == 0) ? (row < MP ? inp(0) + (size_t)row * D : inp(1) + (size_t)(row - MP) * D) : X + (size_t)row * D;
        f32x4 v[4];
#pragma unroll
        for (int j = 0; j < 4; ++j) v[j] = ((const f32x4*)src)[lane + 64 * j];
        if (MODE == 1) {
            float s = 0.f;
#pragma unroll
            for (int j = 0; j < 4; ++j) s += (v[j].x + v[j].y) + (v[j].z + v[j].w);
            const float mean = wave_sum(s) * (1.f / D);
            float s2 = 0.f;
#pragma unroll
            for (int j = 0; j < 4; ++j) { v[j] = v[j] - mean; s2 += (v[j].x * v[j].x + v[j].y * v[j].y) + (v[j].z * v[j].z + v[j].w * v[j].w); }
            const float rstd = rsqrtf(wave_sum(s2) * (1.f / D) + 1e-5f);
#pragma unroll
            for (int j = 0; j < 4; ++j) {
                const f32x4 g = ((const f32x4*)lng)[lane + 64 * j], b = ((const f32x4*)lnb)[lane + 64 * j];
                v[j] = v[j] * rstd * g + b;
            }
        }
#pragma unroll
        for (int j = 0; j < 4; ++j) ((f32x4*)(X + (size_t)row * D))[lane + 64 * j] = v[j];
        if (write_out) {
#pragma unroll
            for (int j = 0; j < 4; ++j) ((f32x4*)(p.out + OUT_Y + (size_t)row * D))[lane + 64 * j] = v[j];
        }
        if (modn) {
            const int cond = row_cond(row);
            const float* sc = modn + cond * 6144 + ch_sc * 1024;
            const float* sh = modn + cond * 6144 + ch_sh * 1024;
#pragma unroll
            for (int j = 0; j < 4; ++j) {
                const f32x4 a = ((const f32x4*)sc)[lane + 64 * j], b = ((const f32x4*)sh)[lane + 64 * j];
                const f32x4 h = v[j] * (a + 1.f) + b;
                u32x2 o; o.x = pk2(h.x, h.y); o.y = pk2(h.z, h.w);
                ((u32x2*)(H + (size_t)row * D))[lane + 64 * j] = o;
            }
        }
    }
}

namespace pg8 {
#define PG8_LAS __attribute__((address_space(3)))
constexpr int BM = 256, BK = 64, HALF = 128, HTB = HALF * BK * 2, STAGE_BYTES = 8 * HTB, NXCD = 8, WGM = 8;
DEVI int lds_byte(int r, int c) { const int st = (r >> 4) * 2 + (c >> 5), rr = r & 15, cc = c & 31, ob = rr * 64 + cc * 2; return st * 1024 + (ob ^ (((ob >> 9) & 1) << 5)); }
DEVI void stage_rc(int b, int& R, int& C) { const int st = b / 1024, sb = b % 1024, swz = sb ^ (((sb >> 9) & 1) << 5); R = (st >> 1) * 16 + swz / 64; C = (st & 1) * 32 + (swz % 64) / 2; }
DEVI int perm32(int rho) { const int n = rho >> 4, i = rho & 15; return 8 * (i >> 2) + 4 * n + (i & 3); }
struct Unit { int pm, pn; };
struct Gemm { const bf16_t* A; const bf16_t* Bt; int M, N, K; };
struct StaticOrder {
    int nM, nN, nwg, G, c;
    DEVI void init(int M, int N, int G_, int c_) { nM = M / BM; nN = N / BM; nwg = nM * nN; G = G_; c = c_; }
    DEVI bool next(int i, Unit& u) const {
        const long L = (long)i * G + c; if (L >= nwg) return false;
        int wgid = (int)L; { const int q = nwg / NXCD, r = nwg % NXCD, xcd = wgid % NXCD, off = wgid / NXCD; wgid = (xcd < r ? xcd * (q + 1) : r * (q + 1) + (xcd - r) * q) + off; }
        const int nig = WGM * nN, gid = wgid / nig, fm = gid * WGM, gsz = (nM - fm) < WGM ? (nM - fm) : WGM;
        u.pm = fm + ((wgid % nig) % gsz); u.pn = (wgid % nig) / gsz; return true;
    }
    DEVI void a_ready(const Unit&) const {}
    DEVI void done(const Unit&) const {}
};
struct EpiStore {
    static constexpr bool PERM = true, AFTER_DRAIN = false;
    bf16_t* O; int ldo;
    DEVI void operator()(const f32x4 (&acc)[2][2][4][2], const Unit& u, int wr, int wc, int fr, int fq) const {
        const int row0 = u.pm * BM + wr * 64 + fr, col0 = u.pn * BM + wc * 32 + 8 * fq;
#pragma unroll
        for (int ai = 0; ai < 2; ++ai)
#pragma unroll
            for (int m = 0; m < 4; ++m) { bf16_t* rowp = O + (size_t)(row0 + ai * HALF + m * 16) * ldo + col0;
#pragma unroll
                for (int bj = 0; bj < 2; ++bj) { const f32x4 v0 = acc[ai][bj][m][0], v1 = acc[ai][bj][m][1];
                    u32x4 w; w.x = pk2(v0[0], v0[1]); w.y = pk2(v0[2], v0[3]); w.z = pk2(v1[0], v1[1]); w.w = pk2(v1[2], v1[3]);
                    *(u32x4*)(rowp + bj * HALF) = w; } }
    }
};
struct EpiSwiglu {
    static constexpr bool PERM = true, AFTER_DRAIN = false;
    bf16_t* O; int ldo;
    DEVI void operator()(const f32x4 (&acc)[2][2][4][2], const Unit& u, int wr, int wc, int fr, int fq) const {
        const int row0 = u.pm * BM + wr * 64 + fr, col0 = u.pn * HALF + wc * 32 + 8 * fq;
#pragma unroll
        for (int ai = 0; ai < 2; ++ai)
#pragma unroll
            for (int m = 0; m < 4; ++m) { bf16_t* rowp = O + (size_t)(row0 + ai * HALF + m * 16) * ldo + col0;
                const f32x4 g0 = acc[ai][0][m][0], g1 = acc[ai][0][m][1], u0 = acc[ai][1][m][0], u1 = acc[ai][1][m][1];
                u32x4 w; w.x = pk2(silu_f(g0[0]) * u0[0], silu_f(g0[1]) * u0[1]); w.y = pk2(silu_f(g0[2]) * u0[2], silu_f(g0[3]) * u0[3]);
                w.z = pk2(silu_f(g1[0]) * u1[0], silu_f(g1[1]) * u1[1]); w.w = pk2(silu_f(g1[2]) * u1[2], silu_f(g1[3]) * u1[3]);
                *(u32x4*)rowp = w; }
    }
};
struct EpiResid {
    static constexpr bool PERM = true, AFTER_DRAIN = false;
    float* X; const float* ga;
    DEVI void operator()(const f32x4 (&acc)[2][2][4][2], const Unit& u, int wr, int wc, int fr, int fq) const {
        const int row0 = u.pm * BM + wr * 64 + fr, col0 = u.pn * BM + wc * 32 + 8 * fq;
        const int cond = u.pm < 16 ? 0 : 1 + ((u.pm - 16) >> 3);
        const float* g = ga + cond * 6144 + col0;
#pragma unroll
        for (int bj = 0; bj < 2; ++bj) {
            const f32x4 g0 = *(const f32x4*)(g + bj * HALF), g1 = *(const f32x4*)(g + bj * HALF + 4);
#pragma unroll
            for (int ai = 0; ai < 2; ++ai)
#pragma unroll
                for (int m = 0; m < 4; ++m) { float* xp = X + (size_t)(row0 + ai * HALF + m * 16) * D + col0 + bj * HALF;
                    const f32x4 x0 = *(const f32x4*)xp, x1 = *(const f32x4*)(xp + 4);
                    *(f32x4*)xp = x0 * ALPHA + g0 * acc[ai][bj][m][0]; *(f32x4*)(xp + 4) = x1 * ALPHA + g1 * acc[ai][bj][m][1]; }
        }
    }
};
template <class Epi, class Sched, bool ALIGN_EPI = false, bool SP2 = false>
__device__ __forceinline__ void gemm_phase(PG8_LAS unsigned char* lds, const Gemm g, const Sched& S, const Epi& E) {
    const int tid = otid(), wid = __builtin_amdgcn_readfirstlane(tid >> 6), lane = tid & 63, wr = wid >> 2, wc = wid & 3, fr = lane & 15, fq = lane >> 4;
    const int K = g.K, nt = K / BK;
    unsigned voffA[2], voffB[2];
#pragma unroll
    for (int i = 0; i < 2; ++i) { int R, C; stage_rc(tid * 16 + i * 8192, R, C); const int Rb = Epi::PERM ? ((R & ~31) + perm32(R & 31)) : R;
        voffA[i] = (unsigned)(R * K + C) * 2u; voffB[i] = (unsigned)(Rb * K + C) * 2u; }
    const size_t kstep = (size_t)(BK * 2);
    const size_t hstep = (size_t)HALF * K * 2;
    const size_t tstep = 2 * hstep;
    const unsigned ldsw = (unsigned)wid * 1024u;
    const int aoff = lds_byte(wr * 64 + fr, fq * 8), boff = lds_byte(wc * 32 + fr, fq * 8);
#define PG8_SA(b, h) (((b) * 2 + (h)) * HTB)
#define PG8_SB(b, h) ((4 + (b) * 2 + (h)) * HTB)
#define PG8_STAGE(bufoff, gbase, voff) do { _Pragma("unroll") for (int _i = 0; _i < 2; ++_i) \
        __builtin_amdgcn_global_load_lds((const unsigned*)((const char*)(gbase) + (voff)[_i]), (PG8_LAS unsigned*)(lds + (bufoff) + ldsw + _i * 8192), 16, 0, 0); } while (0)
#define PG8_LDA(dst, b, h) do { _Pragma("unroll") for (int m = 0; m < 4; ++m) _Pragma("unroll") for (int k = 0; k < 2; ++k) dst[m][k] = *(const PG8_LAS bf16x8*)(lds + PG8_SA(b, h) + aoff + m * 2048 + k * 1024); } while (0)
#define PG8_LDB(dst, b, h) do { _Pragma("unroll") for (int n = 0; n < 2; ++n) _Pragma("unroll") for (int k = 0; k < 2; ++k) dst[n][k] = *(const PG8_LAS bf16x8*)(lds + PG8_SB(b, h) + boff + n * 2048 + k * 1024); } while (0)
#define PG8_MMA(ai, bj, At, Bt) do { __builtin_amdgcn_s_setprio(1); _Pragma("unroll") for (int m = 0; m < 4; ++m) _Pragma("unroll") for (int n = 0; n < 2; ++n) _Pragma("unroll") for (int k = 0; k < 2; ++k) \
        acc[ai][bj][m][n] = __builtin_amdgcn_mfma_f32_16x16x32_bf16(Bt[n][k], At[m][k], acc[ai][bj][m][n], 0, 0, 0); __builtin_amdgcn_s_setprio(0); } while (0)
#define PG8_WAIT_V(n) asm volatile("s_waitcnt vmcnt(" #n ")" ::: "memory")
#define PG8_WAIT_L(n) asm volatile("s_waitcnt lgkmcnt(" #n ")" ::: "memory")
#define PG8_BAR __builtin_amdgcn_s_barrier()
#define PG8_SCHED __builtin_amdgcn_sched_barrier(0)
    Unit cur, nxt; int ui = 0;
    if (!S.next(0, cur)) return;
    f32x4 acc[2][2][4][2];
#pragma unroll
    for (int a = 0; a < 2; ++a)
#pragma unroll
        for (int b = 0; b < 2; ++b)
#pragma unroll
            for (int m = 0; m < 4; ++m)
#pragma unroll
                for (int n = 0; n < 2; ++n) acc[a][b][m][n] = (f32x4){0.f, 0.f, 0.f, 0.f};
    bf16x8 At[4][2], B0[2][2], B1[2][2];
    const char* cA = (const char*)g.A + (size_t)cur.pm * tstep; const char* cB = (const char*)g.Bt + (size_t)cur.pn * tstep;
    S.a_ready(cur);
    if constexpr (SP2) {
        PG8_STAGE(PG8_SB(0, 0), cB, voffB); PG8_STAGE(PG8_SB(0, 1), cB + hstep, voffB); PG8_STAGE(PG8_SA(0, 0), cA, voffA); PG8_STAGE(PG8_SA(0, 1), cA + hstep, voffA);
        if (wr == 1) PG8_BAR;
        PG8_WAIT_V(2); PG8_BAR;
        PG8_STAGE(PG8_SB(1, 0), cB + kstep, voffB); PG8_STAGE(PG8_SA(1, 0), cA + kstep, voffA); PG8_STAGE(PG8_SB(1, 1), cB + hstep + kstep, voffB);
        PG8_WAIT_V(6); PG8_BAR;
    } else {
        PG8_STAGE(PG8_SB(0, 0), cB, voffB); PG8_STAGE(PG8_SA(0, 0), cA, voffA); PG8_STAGE(PG8_SB(0, 1), cB + hstep, voffB); PG8_STAGE(PG8_SA(0, 1), cA + hstep, voffA);
        if (wr == 1) PG8_BAR;
        PG8_WAIT_V(4); PG8_BAR;
        PG8_STAGE(PG8_SB(1, 0), cB + kstep, voffB); PG8_STAGE(PG8_SA(1, 0), cA + kstep, voffA); PG8_STAGE(PG8_SB(1, 1), cB + hstep + kstep, voffB);
        PG8_WAIT_V(6); PG8_BAR;
    }
    for (;;) {
        const bool has_next = S.next(ui + 1, nxt);
        const char* nA = has_next ? (const char*)g.A + (size_t)nxt.pm * tstep : cA; const char* nB = has_next ? (const char*)g.Bt + (size_t)nxt.pn * tstep : cB;
        for (int t = 0; t < nt; t += 2) {
            const bool last = (t == nt - 2);
            const char* a1 = cA + (size_t)(t + 1) * kstep;
            const char* a2 = last ? nA : cA + (size_t)(t + 2) * kstep; const char* b2 = last ? nB : cB + (size_t)(t + 2) * kstep;
            const char* a3 = a2 + kstep; const char* b3 = b2 + kstep;
            if (last && has_next) S.a_ready(nxt);
            if constexpr (SP2) {
            PG8_LDB(B0, 0, 0); PG8_LDB(B1, 0, 1); PG8_SCHED; PG8_LDA(At, 0, 0); PG8_STAGE(PG8_SA(1, 1), a1 + hstep, voffA);
            PG8_WAIT_V(8); PG8_WAIT_L(0); PG8_BAR; PG8_MMA(0, 0, At, B0); PG8_MMA(0, 1, At, B1); PG8_BAR; PG8_SCHED;
            PG8_LDA(At, 0, 1); PG8_STAGE(PG8_SB(0, 0), b2, voffB); PG8_STAGE(PG8_SB(0, 1), b2 + hstep, voffB); PG8_STAGE(PG8_SA(0, 0), a2, voffA);
            PG8_WAIT_V(8); PG8_WAIT_L(0); PG8_BAR; PG8_MMA(1, 0, At, B0); PG8_MMA(1, 1, At, B1); PG8_BAR; PG8_SCHED;
            PG8_LDB(B0, 1, 0); PG8_LDB(B1, 1, 1); PG8_SCHED; PG8_LDA(At, 1, 0); PG8_STAGE(PG8_SA(0, 1), a2 + hstep, voffA);
            PG8_WAIT_V(8); PG8_WAIT_L(0); PG8_BAR; PG8_MMA(0, 0, At, B0); PG8_MMA(0, 1, At, B1); PG8_BAR; PG8_SCHED;
            PG8_LDA(At, 1, 1); PG8_STAGE(PG8_SB(1, 0), b3, voffB); PG8_STAGE(PG8_SB(1, 1), b3 + hstep, voffB); PG8_STAGE(PG8_SA(1, 0), a3, voffA);
            PG8_WAIT_V(8); PG8_WAIT_L(0); PG8_BAR; PG8_MMA(1, 0, At, B0); PG8_MMA(1, 1, At, B1); PG8_BAR; PG8_SCHED;
            } else {
            PG8_LDB(B0, 0, 0); PG8_SCHED; PG8_LDA(At, 0, 0); PG8_STAGE(PG8_SA(1, 1), a1 + hstep, voffA);
            PG8_WAIT_L(8); PG8_BAR; PG8_WAIT_L(0); PG8_MMA(0, 0, At, B0); PG8_BAR; PG8_SCHED;
            PG8_LDB(B1, 0, 1); PG8_STAGE(PG8_SB(0, 0), b2, voffB);
            PG8_BAR; PG8_WAIT_L(0); PG8_MMA(0, 1, At, B1); PG8_BAR;
            PG8_LDA(At, 0, 1); PG8_STAGE(PG8_SA(0, 0), a2, voffA);
            PG8_BAR; PG8_WAIT_L(0); PG8_MMA(1, 0, At, B0); PG8_BAR; PG8_SCHED;
            PG8_STAGE(PG8_SB(0, 1), b2 + hstep, voffB);
            PG8_WAIT_V(6); PG8_BAR; PG8_MMA(1, 1, At, B1); PG8_BAR;
            PG8_LDB(B0, 1, 0); PG8_SCHED; PG8_LDA(At, 1, 0); PG8_STAGE(PG8_SA(0, 1), a2 + hstep, voffA);
            PG8_WAIT_L(8); PG8_BAR; PG8_WAIT_L(0); PG8_MMA(0, 0, At, B0); PG8_BAR; PG8_SCHED;
            PG8_LDB(B1, 1, 1); PG8_STAGE(PG8_SB(1, 0), b3, voffB);
            PG8_BAR; PG8_WAIT_L(0); PG8_MMA(0, 1, At, B1); PG8_BAR;
            PG8_LDA(At, 1, 1); PG8_STAGE(PG8_SA(1, 0), a3, voffA);
            PG8_BAR; PG8_WAIT_L(0); PG8_MMA(1, 0, At, B0); PG8_BAR; PG8_SCHED;
            PG8_STAGE(PG8_SB(1, 1), b3 + hstep, voffB);
            PG8_WAIT_V(6); PG8_BAR; PG8_MMA(1, 1, At, B1); PG8_BAR;
            }
        }
        if constexpr (ALIGN_EPI) { if (wr == 0) PG8_BAR; }
        if constexpr (!Epi::AFTER_DRAIN) { E(acc, cur, wr, wc, fr, fq); S.done(cur); }
        if (!has_next) break;
#pragma unroll
        for (int a = 0; a < 2; ++a)
#pragma unroll
            for (int b = 0; b < 2; ++b)
#pragma unroll
                for (int m = 0; m < 4; ++m)
#pragma unroll
                    for (int n = 0; n < 2; ++n) acc[a][b][m][n] = (f32x4){0.f, 0.f, 0.f, 0.f};
        cur = nxt; cA = nA; cB = nB; ++ui;
        if constexpr (ALIGN_EPI) { if (wr == 1) PG8_BAR; }
    }
    PG8_WAIT_V(0);
    if constexpr (!ALIGN_EPI) { if (wr == 0) PG8_BAR; }
    PG8_BAR;
    if constexpr (Epi::AFTER_DRAIN) { E.fused(acc, cur, wr, wc, fr, fq, lds, wid, lane); S.done(cur); }
#undef PG8_SA
#undef PG8_SB
#undef PG8_STAGE
#undef PG8_LDA
#undef PG8_LDB
#undef PG8_MMA
#undef PG8_WAIT_V
#undef PG8_WAIT_L
#undef PG8_BAR
#undef PG8_SCHED
}
}

DEVI void phase_conv(const Params& p, int j) {
    const bf16_t* U = (const bf16_t*)(p.ws + WS_BIG);
    bf16_t* Z = (bf16_t*)(p.ws + WS_Z);
    const float* cw = inp(13) + (size_t)j * 3 * D;
    for (int it = obid() * NTHREADS + otid(); it < MTOK * 128; it += gridDim.x * NTHREADS) {
        const int row = it >> 7, c8 = (it & 127) * 8;
        int s, Ls; if (row < MP) { s = row & 255; Ls = 256; } else { s = (row - MP) & 2047; Ls = 2048; }
        const bf16_t* ur = U + (size_t)row * 3072;
        const u32x4 bg = *(const u32x4*)(ur + c8);
        const u32x4 c0 = *(const u32x4*)(ur + 1024 + c8), u0 = *(const u32x4*)(ur + 2048 + c8);
        u32x4 cp = {0, 0, 0, 0}, up = cp, cn = cp, un = cp;
        if (s > 0) { cp = *(const u32x4*)(ur - 3072 + 1024 + c8); up = *(const u32x4*)(ur - 3072 + 2048 + c8); }
        if (s < Ls - 1) { cn = *(const u32x4*)(ur + 3072 + 1024 + c8); un = *(const u32x4*)(ur + 3072 + 2048 + c8); }
        float w0[8], w1[8], w2[8];
#pragma unroll
        for (int i = 0; i < 2; ++i) {
            const f32x4 a = *(const f32x4*)(cw + c8 + 4 * i), b = *(const f32x4*)(cw + D + c8 + 4 * i), c = *(const f32x4*)(cw + 2 * D + c8 + 4 * i);
#pragma unroll
            for (int q = 0; q < 4; ++q) { w0[4 * i + q] = a[q]; w1[4 * i + q] = b[q]; w2[4 * i + q] = c[q]; }
        }
        u32x4 o;
#pragma unroll
        for (int q = 0; q < 4; ++q) {
            const float vlo = bflo(bg[q]) * (w0[2 * q] * bflo(cp[q]) * bflo(up[q]) + w1[2 * q] * bflo(c0[q]) * bflo(u0[q]) + w2[2 * q] * bflo(cn[q]) * bflo(un[q]));
            const float vhi = bfhi(bg[q]) * (w0[2 * q + 1] * bfhi(cp[q]) * bfhi(up[q]) + w1[2 * q + 1] * bfhi(c0[q]) * bfhi(u0[q]) + w2[2 * q + 1] * bfhi(cn[q]) * bfhi(un[q]));
            o[q] = pk2(vlo, vhi);
        }
        *(u32x4*)(Z + (size_t)row * D + c8) = o;
    }
}

DEVI void phase_attn_prep(const Params& p, unsigned char* smem) {
    const bf16_t* QKV = (const bf16_t*)(p.ws + WS_BIG);
    bf16_t* Qb = (bf16_t*)(p.ws + WS_AQ);
    bf16_t* KP = (bf16_t*)(p.ws + WS_AKP);
    bf16_t* KS = (bf16_t*)(p.ws + WS_AKS);
    bf16_t* VP = (bf16_t*)(p.ws + WS_AVP);
    bf16_t* VS = (bf16_t*)(p.ws + WS_AVS);
    const float* qg = inp(16); const float* kg = inp(17);
    const int lane = otid() & 63;
    const int gw = obid() * 8 + (otid() >> 6), NW = gridDim.x * 8;
    const int axis = lane >> 5, f = lane & 31;
    const int i1 = axis * 64 + f, i2 = i1 + 32;
    const float freq = exp2f(-(float)f * (13.287712379549449f / 32.f));
    for (int it = gw; it < MTOK * 10; it += NW) {
        const int row = it / 10, slot = it - row * 10;
        const bf16_t* src = QKV + (size_t)row * 1536 + slot * 128;
        float x1 = bf2f(src[i1]), x2 = bf2f(src[i2]);
        const float ss = wave_sum(x1 * x1 + x2 * x2);
        const float rstd = rsqrtf(ss * (1.f / 128.f) + 1e-6f);
        const float* g = slot < 8 ? qg : kg;
        x1 = x1 * rstd * g[i1]; x2 = x2 * rstd * g[i2];
        if (row >= MP) {
            const int s = (row - MP) & 2047;
            const float pos = axis == 0 ? (float)(s >> 6) : (float)(s & 63);
            float sn, cs; sincosf(pos * freq, &sn, &cs);
            const float y1 = x1 * cs - x2 * sn, y2 = x2 * cs + x1 * sn;
            x1 = y1; x2 = y2;
        }
        if (slot < 8) {
            const float sc = 0.08838834764831845f * 1.4426950408889634f;
            bf16_t* d = Qb + (size_t)row * D + slot * 128;
            d[i1] = (bf16_t)(pk2(x1 * sc, 0.f) & 0xffff); d[i2] = (bf16_t)(pk2(x2 * sc, 0.f) & 0xffff);
        } else {
            const int kvh = slot - 8;
            bf16_t* d;
            if (row < MP) {
                d = KP + (size_t)row * 256 + kvh * 128;
                float* o = p.out + OUT_CK + (size_t)row * 256 + kvh * 128;
                o[i1] = x1; o[i2] = x2;
            } else {
                const int b = (row - MP) >> 11, s = (row - MP) & 2047;
                d = KS + ((size_t)b * 2304 + 256 + s) * 256 + kvh * 128;
            }
            d[i1] = (bf16_t)(pk2(x1, 0.f) & 0xffff); d[i2] = (bf16_t)(pk2(x2, 0.f) & 0xffff);
        }
    }
    for (int it = obid() * NTHREADS + otid(); it < 2 * 256 * 256 / 4; it += gridDim.x * NTHREADS) {
        const int e = it * 4, b = e >> 16, r = e & 65535;
        const f32x4 v = *(const f32x4*)(inp(3) + e);
        u32x2 o; o.x = pk2(v.x, v.y); o.y = pk2(v.z, v.w);
        *(u32x2*)(KS + (size_t)b * 2304 * 256 + r) = o;
    }
    bf16_t* vl = (bf16_t*)smem;
    for (int job = obid(); job < 64 + 72; job += gridDim.x) {
        int nkeys, kb; bf16_t* dst; const bf16_t* srcb = nullptr; const float* srcf = nullptr; float* outv = nullptr;
        if (job < 64) { const int b = job >> 2; kb = job & 3; nkeys = 256; dst = VP + (size_t)b * 2 * 128 * 256;
            srcb = QKV + (size_t)(b * 256 + kb * 64) * 1536 + 1280; outv = p.out + OUT_CV + (size_t)(b * 256 + kb * 64) * 256; }
        else { const int jj = job - 64, b = jj / 36; kb = jj - b * 36; nkeys = 2304; dst = VS + (size_t)b * 2 * 128 * 2304;
            if (kb < 4) srcf = inp(4) + (size_t)b * 65536 + (size_t)kb * 64 * 256;
            else srcb = QKV + (size_t)(MP + b * 2048 + (kb - 4) * 64) * 1536 + 1280; }
        for (int c = otid(); c < 64 * 32; c += NTHREADS) {
            const int key = c >> 5, c8 = (c & 31) * 8;
            u32x4 v;
            if (srcb) v = *(const u32x4*)(srcb + (size_t)key * 1536 + c8);
            else { const f32x4 a = *(const f32x4*)(srcf + key * 256 + c8), b2 = *(const f32x4*)(srcf + key * 256 + c8 + 4);
                v.x = pk2(a.x, a.y); v.y = pk2(a.z, a.w); v.z = pk2(b2.x, b2.y); v.w = pk2(b2.z, b2.w); }
            *(u32x4*)(vl + key * 264 + c8) = v;
            if (outv) {
                f32x4 a = {bflo(v.x), bfhi(v.x), bflo(v.y), bfhi(v.y)}, b2 = {bflo(v.z), bfhi(v.z), bflo(v.w), bfhi(v.w)};
                *(f32x4*)(outv + key * 256 + c8) = a; *(f32x4*)(outv + key * 256 + c8 + 4) = b2;
            }
        }
        __syncthreads();
        {
            const int rowv = otid() >> 1, half = otid() & 1;
            bf16_t* drow = dst + (size_t)rowv * nkeys + kb * 64 + half * 32;
#pragma unroll
            for (int q = 0; q < 4; ++q) {
                unsigned w[4];
#pragma unroll
                for (int e = 0; e < 4; ++e) {
                    const int k0 = half * 32 + q * 8 + e * 2;
                    w[e] = (unsigned)vl[k0 * 264 + rowv] | ((unsigned)vl[(k0 + 1) * 264 + rowv] << 16);
                }
                *(u32x4*)(drow + q * 8) = (u32x4){w[0], w[1], w[2], w[3]};
            }
        }
        __syncthreads();
    }
}

constexpr int KSTR = 272, VSTR = 144;
constexpr int ATT_KB = 64 * KSTR, ATT_VB = 128 * VSTR, ATT_BUF = ATT_KB + ATT_VB;
DEVI void phase_attn(const Params& p, unsigned char* smem) {
    const bf16_t* Qb = (const bf16_t*)(p.ws + WS_AQ);
    bf16_t* Z = (bf16_t*)(p.ws + WS_Z);
    const int tid = otid(), wave = tid >> 6, lane = tid & 63, fr = lane & 15, fq = lane >> 4;
    for (int u = obid(); u < 512; u += gridDim.x) {
        int h, nkeys, rowbase; const bf16_t* Kbase; const bf16_t* Vbase;
        if (u < 256) { const int b = u >> 7, qb = u & 15; h = (u >> 4) & 7; nkeys = 2304; rowbase = MP + b * 2048 + qb * 128;
            Kbase = (const bf16_t*)(p.ws + WS_AKS) + (size_t)b * 2304 * 256 + (h >> 2) * 128;
            Vbase = (const bf16_t*)(p.ws + WS_AVS) + (size_t)(b * 2 + (h >> 2)) * 128 * 2304; }
        else { const int v = u - 256, b = v >> 4, qb = v & 1; h = (v >> 1) & 7; nkeys = 256; rowbase = b * 256 + qb * 128;
            Kbase = (const bf16_t*)(p.ws + WS_AKP) + (size_t)b * 256 * 256 + (h >> 2) * 128;
            Vbase = (const bf16_t*)(p.ws + WS_AVP) + (size_t)(b * 2 + (h >> 2)) * 128 * 256; }
        const int ntiles = nkeys >> 6;
        bf16x8 qf[4];
        { const bf16_t* qp = Qb + (size_t)(rowbase + wave * 16 + fr) * D + h * 128 + fq * 8;
#pragma unroll
          for (int ks = 0; ks < 4; ++ks) qf[ks] = *(const bf16x8*)(qp + ks * 32); }
        f32x4 o[8];
#pragma unroll
        for (int dt = 0; dt < 8; ++dt) o[dt] = (f32x4){0, 0, 0, 0};
        float mrun = -1e30f, lsum = 0.f;
        const int kr0 = tid >> 4, kc0 = tid & 15;
        const int vr0 = tid >> 3, vc0 = tid & 7;
        u32x4 kreg[2], vreg[2];
#define ATT_LOAD(t) do { \
        kreg[0] = *(const u32x4*)(Kbase + (size_t)((t) * 64 + kr0) * 256 + kc0 * 8); \
        kreg[1] = *(const u32x4*)(Kbase + (size_t)((t) * 64 + kr0 + 32) * 256 + kc0 * 8); \
        vreg[0] = *(const u32x4*)(Vbase + (size_t)vr0 * nkeys + (t) * 64 + vc0 * 8); \
        vreg[1] = *(const u32x4*)(Vbase + (size_t)(vr0 + 64) * nkeys + (t) * 64 + vc0 * 8); } while (0)
#define ATT_STORE(buf) do { unsigned char* kb_ = smem + (buf) * ATT_BUF; unsigned char* vb_ = kb_ + ATT_KB; \
        *(u32x4*)(kb_ + kr0 * KSTR + kc0 * 16) = kreg[0]; *(u32x4*)(kb_ + (kr0 + 32) * KSTR + kc0 * 16) = kreg[1]; \
        *(u32x4*)(vb_ + vr0 * VSTR + vc0 * 16) = vreg[0]; *(u32x4*)(vb_ + (vr0 + 64) * VSTR + vc0 * 16) = vreg[1]; } while (0)
        ATT_LOAD(0); ATT_STORE(0);
        __syncthreads();
        for (int t = 0; t < ntiles; ++t) {
            if (t + 1 < ntiles) ATT_LOAD(t + 1);
            const unsigned char* kb = smem + (t & 1) * ATT_BUF; const unsigned char* vb = kb + ATT_KB;
            f32x4 s[4];
#pragma unroll
            for (int kt = 0; kt < 4; ++kt) {
                s[kt] = (f32x4){0, 0, 0, 0};
#pragma unroll
                for (int ks = 0; ks < 4; ++ks) {
                    const bf16x8 kf = *(const bf16x8*)(kb + (kt * 16 + fr) * KSTR + (ks * 32 + fq * 8) * 2);
                    s[kt] = __builtin_amdgcn_mfma_f32_16x16x32_bf16(kf, qf[ks], s[kt], 0, 0, 0);
                }
            }
            float mx = -1e30f;
#pragma unroll
            for (int kt = 0; kt < 4; ++kt) mx = fmaxf(mx, fmaxf(fmaxf(s[kt].x, s[kt].y), fmaxf(s[kt].z, s[kt].w)));
            mx = fmaxf(mx, __shfl_xor(mx, 16)); mx = fmaxf(mx, __shfl_xor(mx, 32));
            const float mnew = fmaxf(mrun, mx);
            const float alpha = exp2f(mrun - mnew);
            mrun = mnew;
            float ps = 0.f;
#pragma unroll
            for (int kt = 0; kt < 4; ++kt) {
                s[kt].x = exp2f(s[kt].x - mnew); s[kt].y = exp2f(s[kt].y - mnew); s[kt].z = exp2f(s[kt].z - mnew); s[kt].w = exp2f(s[kt].w - mnew);
                ps += (s[kt].x + s[kt].y) + (s[kt].z + s[kt].w);
            }
            lsum = lsum * alpha + ps;
#pragma unroll
            for (int dt = 0; dt < 8; ++dt) o[dt] = o[dt] * alpha;
#pragma unroll
            for (int k2 = 0; k2 < 2; ++k2) {
                u32x4 pw; pw.x = pk2(s[2 * k2].x, s[2 * k2].y); pw.y = pk2(s[2 * k2].z, s[2 * k2].w);
                pw.z = pk2(s[2 * k2 + 1].x, s[2 * k2 + 1].y); pw.w = pk2(s[2 * k2 + 1].z, s[2 * k2 + 1].w);
                const bf16x8 pf = __builtin_bit_cast(bf16x8, pw);
#pragma unroll
                for (int dt = 0; dt < 8; ++dt) {
                    const unsigned char* vp = vb + (dt * 16 + fr) * VSTR + (k2 * 32 + fq * 4) * 2;
                    const u32x2 va = *(const u32x2*)vp, vc = *(const u32x2*)(vp + 32);
                    const u32x4 vw = {va.x, va.y, vc.x, vc.y};
                    o[dt] = __builtin_amdgcn_mfma_f32_16x16x32_bf16(__builtin_bit_cast(bf16x8, vw), pf, o[dt], 0, 0, 0);
                }
            }
            if (t + 1 < ntiles) ATT_STORE((t + 1) & 1);
            __syncthreads();
        }
        lsum += __shfl_xor(lsum, 16); lsum += __shfl_xor(lsum, 32);
        const float inv = 1.f / lsum;
        bf16_t* zp = Z + (size_t)(rowbase + wave * 16 + fr) * D + h * 128 + fq * 4;
#pragma unroll
        for (int dt = 0; dt < 8; ++dt) {
            u32x2 w; w.x = pk2(o[dt].x * inv, o[dt].y * inv); w.y = pk2(o[dt].z * inv, o[dt].w * inv);
            *(u32x2*)(zp + dt * 16) = w;
        }
#undef ATT_LOAD
#undef ATT_STORE
    }
}

constexpr int GLD = 3328;
constexpr int G_R1 = 65536;
constexpr int QK_STR = 136;
constexpr int T_STR = 72;
DEVI void phase_gla_a(const Params& p, unsigned char* smem) {
    const bf16_t* BIGb = (const bf16_t*)(p.ws + WS_BIG);
    bf16_t* GQ = (bf16_t*)(p.ws + WS_GQ);
    bf16_t* GA = (bf16_t*)(p.ws + WS_GA);
    float* GG = (float*)(p.ws + WS_GG);
    bf16_t* GU = (bf16_t*)(p.ws + WS_GU);
    bf16_t* GVT = (bf16_t*)(p.ws + WS_GVT);
    float* bc = (float*)smem;
    unsigned char* r1 = smem + G_R1;
    const int tid = otid(), wave = tid >> 6, lane = tid & 63, fr = lane & 15, fq = lane >> 4;
    for (int unit = obid(); unit < 512; unit += gridDim.x) {
        const int c = unit >> 2, h = unit & 3, r0 = c * 64;
        float* rl = (float*)r1;
        float* w2l = rl + 64 * 33;
        float* bl = w2l + 2 * 16 * 128;
        for (int i = tid; i < 64 * 32; i += NTHREADS) { const int t = i >> 5, q = i & 31; rl[t * 33 + q] = bf2f(BIGb[(size_t)(r0 + t) * GLD + 3072 + q]); }
        for (int i = tid; i < 2 * 16 * 128; i += NTHREADS) { const int dir = i >> 11, rk = (i >> 7) & 15, d = i & 127; w2l[i] = inp(21)[(size_t)(dir * 16 + rk) * 512 + h * 128 + d]; }
        if (tid < 256) { const int dir = tid >> 7, d = tid & 127; bl[tid] = inp(22)[dir * 512 + h * 128 + d]; }
        __syncthreads();
        for (int i = tid; i < 2 * 64 * 128; i += NTHREADS) {
            const int dir = i >> 13, t = (i >> 7) & 63, d = i & 127;
            float z = bl[dir * 128 + d];
#pragma unroll
            for (int q = 0; q < 16; ++q) z += rl[t * 33 + dir * 16 + q] * w2l[(dir * 16 + q) * 128 + d];
            const float ls = fminf(z, 0.f) - log1pf(__expf(-fabsf(z)));
            bc[i] = ls * (1.f / 16.f);
        }
        __syncthreads();
        if (tid < 256) {
            const int dir = tid >> 7, d = tid & 127;
            float run = 0.f;
            if (dir == 0) { for (int t = 0; t < 64; ++t) { run += bc[t * 128 + d]; bc[t * 128 + d] = run; } }
            else { for (int t = 63; t >= 0; --t) { run += bc[8192 + t * 128 + d]; bc[8192 + t * 128 + d] = run; } }
        }
        __syncthreads();
        bf16_t* qk = (bf16_t*)r1;
        for (int i = tid; i < 64 * 16; i += NTHREADS) {
            const int t = i >> 4, d8 = (i & 15) * 8;
            const u32x4 qv = *(const u32x4*)(BIGb + (size_t)(r0 + t) * GLD + h * 128 + d8);
            const u32x4 kv = *(const u32x4*)(BIGb + (size_t)(r0 + t) * GLD + 512 + h * 128 + d8);
            u32x4 oqf, oqb, okf, okb;
#pragma unroll
            for (int q = 0; q < 4; ++q) {
                const float bf0 = bc[t * 128 + d8 + 2 * q], bf1 = bc[t * 128 + d8 + 2 * q + 1];
                const float bb0 = bc[8192 + t * 128 + d8 + 2 * q], bb1 = bc[8192 + t * 128 + d8 + 2 * q + 1];
                const float q0 = bflo(qv[q]) * 0.08838834764831845f, q1 = bfhi(qv[q]) * 0.08838834764831845f;
                const float k0 = bflo(kv[q]), k1 = bfhi(kv[q]);
                oqf[q] = pk2(q0 * __expf(bf0), q1 * __expf(bf1));
                oqb[q] = pk2(q0 * __expf(bb0), q1 * __expf(bb1));
                okf[q] = pk2(k0 * __expf(-bf0), k1 * __expf(-bf1));
                okb[q] = pk2(k0 * __expf(-bb0), k1 * __expf(-bb1));
            }
            *(u32x4*)(qk + (0 * 64 + t) * QK_STR + d8) = oqf;
            *(u32x4*)(qk + (1 * 64 + t) * QK_STR + d8) = oqb;
            *(u32x4*)(qk + (2 * 64 + t) * QK_STR + d8) = okf;
            *(u32x4*)(qk + (3 * 64 + t) * QK_STR + d8) = okb;
            *(u32x4*)(GQ + (size_t)(r0 + t) * 512 + h * 128 + d8) = oqf;
            *(u32x4*)(GQ + (size_t)(MTOK + r0 + t) * 512 + h * 128 + d8) = oqb;
        }
        if (tid < 256) { const int dir = tid >> 7, d = tid & 127;
            GG[(size_t)(unit * 2 + dir) * 128 + d] = __expf(dir == 0 ? bc[63 * 128 + d] : bc[8192 + d]); }
        __syncthreads();
        {
            const int tr = wave & 3;
#pragma unroll
            for (int cc = 0; cc < 2; ++cc) {
                const int tc = (wave >> 2) * 2 + cc;
                f32x4 af = {0, 0, 0, 0}, ab = {0, 0, 0, 0};
#pragma unroll
                for (int ks = 0; ks < 4; ++ks) {
                    const bf16x8 qf_ = *(const bf16x8*)(qk + (0 * 64 + tr * 16 + fr) * QK_STR + ks * 32 + fq * 8);
                    const bf16x8 qb_ = *(const bf16x8*)(qk + (1 * 64 + tr * 16 + fr) * QK_STR + ks * 32 + fq * 8);
                    const bf16x8 kf_ = *(const bf16x8*)(qk + (2 * 64 + tc * 16 + fr) * QK_STR + ks * 32 + fq * 8);
                    const bf16x8 kb_ = *(const bf16x8*)(qk + (3 * 64 + tc * 16 + fr) * QK_STR + ks * 32 + fq * 8);
                    af = __builtin_amdgcn_mfma_f32_16x16x32_bf16(kf_, qf_, af, 0, 0, 0);
                    ab = __builtin_amdgcn_mfma_f32_16x16x32_bf16(kb_, qb_, ab, 0, 0, 0);
                }
                const int t = tr * 16 + fr, s0 = tc * 16 + fq * 4;
                float a[4];
#pragma unroll
                for (int j = 0; j < 4; ++j) { const int s = s0 + j; a[j] = (t >= s ? af[j] : 0.f) + (s >= t ? ab[j] : 0.f); }
                u32x2 w; w.x = pk2(a[0], a[1]); w.y = pk2(a[2], a[3]);
                *(u32x2*)(GA + ((size_t)unit * 64 + t) * 64 + s0) = w;
            }
        }
        __syncthreads();
        bf16_t* khT = (bf16_t*)r1;
        bf16_t* vT = khT + 2 * 128 * T_STR;
        for (int i = tid; i < 64 * 16; i += NTHREADS) {
            const int s = i & 63, d8 = (i >> 6) * 8;
            const u32x4 kv = *(const u32x4*)(BIGb + (size_t)(r0 + s) * GLD + 512 + h * 128 + d8);
#pragma unroll
            for (int q = 0; q < 8; ++q) {
                const int d = d8 + q;
                const float k = (q & 1) ? bfhi(kv[q >> 1]) : bflo(kv[q >> 1]);
                const float ef = __expf(bc[63 * 128 + d] - bc[s * 128 + d]);
                const float eb = __expf(bc[8192 + d] - bc[8192 + s * 128 + d]);
                khT[(0 * 128 + d) * T_STR + s] = (bf16_t)(pk2(k * ef, 0.f) & 0xffff);
                khT[(1 * 128 + d) * T_STR + s] = (bf16_t)(pk2(k * eb, 0.f) & 0xffff);
            }
        }
        for (int i = tid; i < 64 * 32; i += NTHREADS) {
            const int s = i & 63, e8 = (i >> 6) * 8;
            const u32x4 vv = *(const u32x4*)(BIGb + (size_t)(r0 + s) * GLD + 1024 + h * 256 + e8);
#pragma unroll
            for (int q = 0; q < 4; ++q) { vT[(e8 + 2 * q) * T_STR + s] = (bf16_t)(vv[q] & 0xffff); vT[(e8 + 2 * q + 1) * T_STR + s] = (bf16_t)(vv[q] >> 16); }
        }
        __syncthreads();
        for (int i = tid; i < 256 * 8; i += NTHREADS) {
            const int e = i >> 3, cch = i & 7;
            *(u32x4*)(GVT + ((size_t)unit * 256 + e) * 64 + cch * 8) = *(const u32x4*)(vT + e * T_STR + cch * 8);
        }
        {
            const int dir = wave >> 2;
            bf16_t* Uo = GU + (size_t)(unit * 2 + dir) * 256 * 128;
#pragma unroll 1
            for (int eh = 0; eh < 2; ++eh) {
                f32x4 acc[2][8];
#pragma unroll
                for (int a = 0; a < 2; ++a)
#pragma unroll
                    for (int b = 0; b < 8; ++b) acc[a][b] = (f32x4){0, 0, 0, 0};
#pragma unroll
                for (int ks = 0; ks < 2; ++ks) {
                    bf16x8 af[2];
#pragma unroll
                    for (int a = 0; a < 2; ++a) af[a] = *(const bf16x8*)(khT + (dir * 128 + ((wave & 3) * 2 + a) * 16 + fr) * T_STR + ks * 32 + fq * 8);
#pragma unroll
                    for (int b = 0; b < 8; ++b) {
                        const bf16x8 bfv = *(const bf16x8*)(vT + ((eh * 8 + b) * 16 + fr) * T_STR + ks * 32 + fq * 8);
#pragma unroll
                        for (int a = 0; a < 2; ++a) acc[a][b] = __builtin_amdgcn_mfma_f32_16x16x32_bf16(af[a], bfv, acc[a][b], 0, 0, 0);
                    }
                }
#pragma unroll
                for (int a = 0; a < 2; ++a)
#pragma unroll
                    for (int b = 0; b < 8; ++b) {
                        const int d0 = ((wave & 3) * 2 + a) * 16 + fq * 4, e = (eh * 8 + b) * 16 + fr;
                        u32x2 w; w.x = pk2(acc[a][b].x, acc[a][b].y); w.y = pk2(acc[a][b].z, acc[a][b].w);
                        *(u32x2*)(Uo + (size_t)e * 128 + d0) = w;
                    }
            }
        }
        __syncthreads();
    }
}

DEVI void phase_gla_scan(const Params& p) {
    bf16_t* GU = (bf16_t*)(p.ws + WS_GU);
    const float* GG = (const float*)(p.ws + WS_GG);
    const int T = gridDim.x * NTHREADS;
    for (int id = obid() * NTHREADS + otid(); id < 65536 + 524288; id += T) {
        int b, h, dir, e, d8, nc, c0; bool sample = id < 65536;
        int v = sample ? id : id - 65536;
        d8 = (v & 15) * 8; e = (v >> 4) & 255; dir = (v >> 12) & 1; h = (v >> 13) & 3; b = v >> 15;
        if (sample) { nc = 32; c0 = 64 + b * 32; } else { nc = 4; c0 = b * 4; }
        float run[8];
        if (sample) {
            const float* s0f = inp(5); const float* s0b = inp(6);
            const float* s0 = (dir == 0 ? s0f : s0b) + (size_t)(b * 4 + h) * 32768 + e;
#pragma unroll
            for (int q = 0; q < 8; ++q) run[q] = s0[(size_t)(d8 + q) * 256];
        } else {
#pragma unroll
            for (int q = 0; q < 8; ++q) run[q] = 0.f;
        }
        for (int i = 0; i < nc; ++i) {
            const int cs = dir == 0 ? i : nc - 1 - i;
            const int unit = (c0 + cs) * 4 + h;
            bf16_t* up = GU + ((size_t)(unit * 2 + dir) * 256 + e) * 128 + d8;
            const float* gp = GG + (size_t)(unit * 2 + dir) * 128 + d8;
            const u32x4 uv = *(const u32x4*)up;
            const f32x4 g0 = *(const f32x4*)gp, g1 = *(const f32x4*)(gp + 4);
            u32x4 sv; sv.x = pk2(run[0], run[1]); sv.y = pk2(run[2], run[3]); sv.z = pk2(run[4], run[5]); sv.w = pk2(run[6], run[7]);
            *(u32x4*)up = sv;
            run[0] = g0.x * run[0] + bflo(uv.x); run[1] = g0.y * run[1] + bfhi(uv.x);
            run[2] = g0.z * run[2] + bflo(uv.y); run[3] = g0.w * run[3] + bfhi(uv.y);
            run[4] = g1.x * run[4] + bflo(uv.z); run[5] = g1.y * run[5] + bfhi(uv.z);
            run[6] = g1.z * run[6] + bflo(uv.w); run[7] = g1.w * run[7] + bfhi(uv.w);
        }
        if (!sample) {
            float* o = p.out + (dir == 0 ? OUT_SF : OUT_SB) + (size_t)(b * 4 + h) * 32768 + e;
#pragma unroll
            for (int q = 0; q < 8; ++q) o[(size_t)(d8 + q) * 256] = run[q];
        }
    }
}

constexpr int AOP_STR = 328;
DEVI void phase_gla_c(const Params& p, unsigned char* smem) {
    const bf16_t* BIGb = (const bf16_t*)(p.ws + WS_BIG);
    const bf16_t* GQ = (const bf16_t*)(p.ws + WS_GQ);
    const bf16_t* GA = (const bf16_t*)(p.ws + WS_GA);
    const bf16_t* GU = (const bf16_t*)(p.ws + WS_GU);
    const bf16_t* GVT = (const bf16_t*)(p.ws + WS_GVT);
    bf16_t* Z = (bf16_t*)(p.ws + WS_Z);
    const float* ng = inp(23);
    bf16_t* aop = (bf16_t*)smem;
    float* red = (float*)(smem + 64 * AOP_STR * 2);
    const int tid = otid(), wave = tid >> 6, lane = tid & 63, fr = lane & 15, fq = lane >> 4;
    for (int unit = obid(); unit < 512; unit += gridDim.x) {
        const int c = unit >> 2, h = unit & 3, r0 = c * 64;
        for (int i = tid; i < 64 * 40; i += NTHREADS) {
            const int t = i / 40, ch = i - t * 40;
            u32x4 v;
            if (ch < 8) v = *(const u32x4*)(GA + ((size_t)unit * 64 + t) * 64 + ch * 8);
            else if (ch < 24) v = *(const u32x4*)(GQ + (size_t)(r0 + t) * 512 + h * 128 + (ch - 8) * 8);
            else v = *(const u32x4*)(GQ + (size_t)(MTOK + r0 + t) * 512 + h * 128 + (ch - 24) * 8);
            *(u32x4*)(aop + t * AOP_STR + ch * 8) = v;
        }
        __syncthreads();
        f32x4 acc[2][4];
#pragma unroll
        for (int a = 0; a < 2; ++a)
#pragma unroll
            for (int b = 0; b < 4; ++b) acc[a][b] = (f32x4){0, 0, 0, 0};
#pragma unroll
        for (int ks = 0; ks < 10; ++ks) {
            bf16x8 ef[2];
#pragma unroll
            for (int a = 0; a < 2; ++a) {
                const int e = (wave * 2 + a) * 16 + fr;
                const bf16_t* src;
                if (ks < 2) src = GVT + ((size_t)unit * 256 + e) * 64 + ks * 32 + fq * 8;
                else if (ks < 6) src = GU + ((size_t)(unit * 2 + 0) * 256 + e) * 128 + (ks - 2) * 32 + fq * 8;
                else src = GU + ((size_t)(unit * 2 + 1) * 256 + e) * 128 + (ks - 6) * 32 + fq * 8;
                ef[a] = *(const bf16x8*)src;
            }
#pragma unroll
            for (int b = 0; b < 4; ++b) {
                const bf16x8 tf = *(const bf16x8*)(aop + (b * 16 + fr) * AOP_STR + ks * 32 + fq * 8);
#pragma unroll
                for (int a = 0; a < 2; ++a) acc[a][b] = __builtin_amdgcn_mfma_f32_16x16x32_bf16(ef[a], tf, acc[a][b], 0, 0, 0);
            }
        }
#pragma unroll
        for (int b = 0; b < 4; ++b) {
            float ss = 0.f;
#pragma unroll
            for (int a = 0; a < 2; ++a) ss += (acc[a][b].x * acc[a][b].x + acc[a][b].y * acc[a][b].y) + (acc[a][b].z * acc[a][b].z + acc[a][b].w * acc[a][b].w);
            ss += __shfl_xor(ss, 16); ss += __shfl_xor(ss, 32);
            if (fq == 0) red[wave * 64 + b * 16 + fr] = ss;
        }
        __syncthreads();
#pragma unroll
        for (int b = 0; b < 4; ++b) {
            const int t = b * 16 + fr;
            float tot = 0.f;
#pragma unroll
            for (int w = 0; w < 8; ++w) tot += red[w * 64 + t];
            const float rstd = rsqrtf(tot * (1.f / 256.f) + 1e-6f);
#pragma unroll
            for (int a = 0; a < 2; ++a) {
                const int e0 = (wave * 2 + a) * 16 + fq * 4;
                const u32x2 ogv = *(const u32x2*)(BIGb + (size_t)(r0 + t) * GLD + 2048 + h * 256 + e0);
                const f32x4 g = *(const f32x4*)(ng + e0);
                const float o0 = acc[a][b].x * rstd * g.x * silu_f(bflo(ogv.x));
                const float o1 = acc[a][b].y * rstd * g.y * silu_f(bfhi(ogv.x));
                const float o2 = acc[a][b].z * rstd * g.z * silu_f(bflo(ogv.y));
                const float o3 = acc[a][b].w * rstd * g.w * silu_f(bfhi(ogv.y));
                u32x2 w; w.x = pk2(o0, o1); w.y = pk2(o2, o3);
                *(u32x2*)(Z + (size_t)(r0 + t) * D + h * 256 + e0) = w;
            }
        }
        __syncthreads();
    }
}

template <class Epi>
DEVI void run_gemm(unsigned char* smem, const bf16_t* A, const bf16_t* Bt, int N, int K, const Epi& E) {
    pg8::Gemm g{A, Bt, MTOK, N, K};
    pg8::StaticOrder S; S.init(MTOK, N, (int)gridDim.x, obid());
    pg8::gemm_phase<Epi, pg8::StaticOrder, true, true>((PG8_LAS unsigned char*)smem, g, S, E);
}

__global__ void __launch_bounds__(NTHREADS) mega_fwd(Params p) {
    extern __shared__ __attribute__((aligned(16))) unsigned char smem[];
    cg::grid_group grid = cg::this_grid();
#define GSYNC() do { __threadfence(); grid.sync(); } while (0)

    phase_prep(p, smem);
    GSYNC();
    phase_modfinal(p);
    GSYNC();
    phase_rows<0>(p, nullptr, nullptr, (const float*)(p.ws + WS_MOD), 0, 1, false);
    GSYNC();
#ifndef DBG_LAYERS
#define DBG_LAYERS 4
#endif
#pragma unroll 1
    for (int l = 0; l < DBG_LAYERS; ++l) {
        const int kind = l % 3, j = l / 3;
        {
            const bf16_t* Win; int Nin;
            if (kind == 0) { Win = (const bf16_t*)(p.ws + WS_WCIN) + (size_t)j * 3072 * 1024; Nin = 3072; }
            else if (kind == 1) { Win = (const bf16_t*)(p.ws + WS_WQKV); Nin = 1536; }
            else { Win = (const bf16_t*)(p.ws + WS_WGIN); Nin = 3328; }
            pg8::EpiStore E{(bf16_t*)(p.ws + WS_BIG), Nin};
            run_gemm(smem, (const bf16_t*)(p.ws + WS_H), Win, Nin, 1024, E);
        }
        GSYNC();
        if (kind == 0) { phase_conv(p, j); }
        else if (kind == 1) { phase_attn_prep(p, smem); GSYNC(); phase_attn(p, smem); }
        else { phase_gla_a(p, smem); GSYNC(); phase_gla_scan(p); GSYNC(); phase_gla_c(p, smem); }
        GSYNC();
        {
            const bf16_t* Wout;
            if (kind == 0) Wout = (const bf16_t*)(p.ws + WS_WCOUT) + (size_t)j * 1024 * 1024;
            else if (kind == 1) Wout = (const bf16_t*)(p.ws + WS_WAO);
            else Wout = (const bf16_t*)(p.ws + WS_WGO);
            pg8::EpiResid E{(float*)(p.ws + WS_X), (const float*)(p.ws + WS_MOD) + (size_t)l * 3 * 6144 + 2 * 1024};
            run_gemm(smem, (const bf16_t*)(p.ws + WS_Z), Wout, 1024, 1024, E);
        }
        GSYNC();
        phase_rows<1>(p, inp(10) + (size_t)(l * 2 + 0) * D, inp(11) + (size_t)(l * 2 + 0) * D, (const float*)(p.ws + WS_MOD) + (size_t)l * 3 * 6144, 3, 4, false);
        GSYNC();
        {
            pg8::EpiSwiglu E{(bf16_t*)(p.ws + WS_BIG), DFF};
            run_gemm(smem, (const bf16_t*)(p.ws + WS_H), (const bf16_t*)(p.ws + WS_WFIN) + (size_t)l * 5632 * 1024, 5632, 1024, E);
        }
        GSYNC();
        {
            pg8::EpiResid E{(float*)(p.ws + WS_X), (const float*)(p.ws + WS_MOD) + (size_t)l * 3 * 6144 + 5 * 1024};
            run_gemm(smem, (const bf16_t*)(p.ws + WS_BIG), (const bf16_t*)(p.ws + WS_WFOUT) + (size_t)l * 1024 * 2816, 1024, 2816, E);
        }
        GSYNC();
        phase_rows<1>(p, inp(10) + (size_t)(l * 2 + 1) * D, inp(11) + (size_t)(l * 2 + 1) * D,
                      l < 3 ? (const float*)(p.ws + WS_MOD) + (size_t)(l + 1) * 3 * 6144 : nullptr, 0, 1, l == DBG_LAYERS - 1);
        GSYNC();
    }
}

extern "C" void kernel_launch(void* const* d_in, const int* in_sizes, int n_in, void* d_out, int out_size, void* d_ws, size_t ws_size, hipStream_t stream) {
    static int grid_blocks = 0;
    if (grid_blocks == 0) {
        if (n_in != 27 || ws_size < WS_END) { fprintf(stderr, "kernel_launch: unexpected n_in %d or ws_size %zu (< %zu)\n", n_in, ws_size, (size_t)WS_END); grid_blocks = -1; return; }
        int dev = 0, cus = 0, per_cu = 0;
        hipGetDevice(&dev);
        hipDeviceGetAttribute(&cus, hipDeviceAttributeMultiprocessorCount, dev);
        hipFuncSetAttribute((const void*)mega_fwd, hipFuncAttributeMaxDynamicSharedMemorySize, LDS_BYTES);
        hipOccupancyMaxActiveBlocksPerMultiprocessor(&per_cu, (const void*)mega_fwd, NTHREADS, LDS_BYTES);
        if (per_cu < 1) per_cu = 1;
        grid_blocks = cus * 1;
        (void)hipGetLastError();
    }
    if (grid_blocks < 0) return;
    Params p{};
    for (int i = 0; i < 27; ++i) p.in[i] = (const float*)d_in[i];
    p.out = (float*)d_out; p.ws = (unsigned char*)d_ws;
    void* args[] = {&p};
    hipError_t e = hipLaunchCooperativeKernel((const void*)mega_fwd, dim3(grid_blocks), dim3(NTHREADS), args, LDS_BYTES, stream);
    if (e != hipSuccess) fprintf(stderr, "cooperative launch failed: %s (grid %d)\n", hipGetErrorString(e), grid_blocks);
}
#ifdef PHASE_TEST
__global__ void __launch_bounds__(NTHREADS) t_gemm0(Params p, int N) { extern __shared__ __attribute__((aligned(16))) unsigned char smem[]; pg8::EpiStore E{(bf16_t*)(p.ws + WS_BIG), N}; run_gemm(smem, (const bf16_t*)(p.ws + WS_H), (const bf16_t*)(p.ws + WS_WCIN), N, 1024, E); }
__global__ void __launch_bounds__(NTHREADS) t_gemm1(Params p) { extern __shared__ __attribute__((aligned(16))) unsigned char smem[]; pg8::EpiSwiglu E{(bf16_t*)(p.ws + WS_BIG), DFF}; run_gemm(smem, (const bf16_t*)(p.ws + WS_H), (const bf16_t*)(p.ws + WS_WFIN), 5632, 1024, E); }
__global__ void __launch_bounds__(NTHREADS) t_gemm2(Params p, int K) { extern __shared__ __attribute__((aligned(16))) unsigned char smem[]; pg8::EpiResid E{(float*)(p.ws + WS_X), (const float*)(p.ws + WS_MOD)}; run_gemm(smem, (const bf16_t*)(p.ws + WS_Z), (const bf16_t*)(p.ws + WS_WCOUT), 1024, K, E); }
#endif
```

```cpp
#include <hip/hip_runtime.h>
#include <hip/hip_cooperative_groups.h>
#include <cstdio>
#include <cstdint>
namespace cg = cooperative_groups;

typedef unsigned short bf16_t;
typedef short bf16x8 __attribute__((ext_vector_type(8)));
typedef float f32x4 __attribute__((ext_vector_type(4)));
typedef unsigned u32x4 __attribute__((ext_vector_type(4)));
typedef unsigned u32x2 __attribute__((ext_vector_type(2)));
#define DEVI __device__ __forceinline__

constexpr int D = 1024, MTOK = 8192, MP = 4096, DFF = 2816;
constexpr float ALPHA = 1.6817928305074290f;
constexpr int NTHREADS = 512;
constexpr int LDS_BYTES = 139264;

constexpr size_t WS_WCIN  = 0;
constexpr size_t WS_WCOUT = WS_WCIN  + 2ull * 3072 * 1024 * 2;
constexpr size_t WS_WQKV  = WS_WCOUT + 2ull * 1024 * 1024 * 2;
constexpr size_t WS_WAO   = WS_WQKV  + 1536ull * 1024 * 2;
constexpr size_t WS_WGIN  = WS_WAO   + 1024ull * 1024 * 2;
constexpr size_t WS_WGO   = WS_WGIN  + 3328ull * 1024 * 2;
constexpr size_t WS_WFIN  = WS_WGO   + 1024ull * 1024 * 2;
constexpr size_t WS_WFOUT = WS_WFIN  + 4ull * 5632 * 1024 * 2;
constexpr size_t WS_MODP  = WS_WFOUT + 4ull * 1024 * 2816 * 2;
constexpr size_t WS_MOD   = WS_MODP  + 16ull * 4 * 3 * 6144 * 4;
constexpr size_t WS_X     = WS_MOD   + 4ull * 3 * 6144 * 4;
constexpr size_t WS_H     = WS_X     + 8192ull * 1024 * 4;
constexpr size_t WS_BIG   = WS_H     + 8192ull * 1024 * 2;
constexpr size_t WS_Z     = WS_BIG   + 8192ull * 3328 * 2;
constexpr size_t WS_GQ    = WS_Z     + 8192ull * 1024 * 2;
constexpr size_t WS_GA    = WS_GQ    + 2ull * 8192 * 512 * 2;
constexpr size_t WS_GG    = WS_GA    + 512ull * 64 * 64 * 2;
constexpr size_t WS_GU    = WS_GG    + 1024ull * 128 * 4;
constexpr size_t WS_END   = WS_GU    + 1024ull * 256 * 128 * 2;
constexpr size_t WS_GVT   = WS_H;
constexpr size_t WS_AQ    = WS_BIG + 8192ull * 1536 * 2;
constexpr size_t WS_AKP   = WS_AQ  + 8192ull * 1024 * 2;
constexpr size_t WS_AKS   = WS_AKP + 16ull * 256 * 256 * 2;
constexpr size_t WS_AVP   = WS_AKS + 2ull * 2304 * 256 * 2;
constexpr size_t WS_AVS   = WS_AVP + 16ull * 2 * 128 * 256 * 2;
static_assert(WS_AVS + 2ull * 2 * 128 * 2304 * 2 <= WS_Z, "attention buffers overflow BIG");

constexpr size_t OUT_Y = 0, OUT_CK = 8388608, OUT_CV = 9437184, OUT_SF = 10485760, OUT_SB = 12582912;

struct Params {
    const float* in[27];
    float* out;
    unsigned char* ws;
};
__device__ __forceinline__ int otid() { int t = threadIdx.x; asm volatile("" : "+v"(t)); return t; }
__device__ __forceinline__ int obid() { int b = blockIdx.x; asm volatile("" : "+s"(b)); return b; }
__device__ __forceinline__ const float* inp(int i) {
    const float* const* ka = (const float* const*)__builtin_amdgcn_kernarg_segment_ptr();
    asm volatile("" : "+s"(i));
    return ka[i];
}

typedef float f32x2_t __attribute__((ext_vector_type(2)));
typedef __bf16 bf16x2_t __attribute__((ext_vector_type(2)));
DEVI unsigned pk2(float lo, float hi) { f32x2_t v = {lo, hi}; bf16x2_t b = __builtin_convertvector(v, bf16x2_t); return __builtin_bit_cast(unsigned, b); }
DEVI float bflo(unsigned u) { return __uint_as_float(u << 16); }
DEVI float bfhi(unsigned u) { return __uint_as_float(u & 0xffff0000u); }
DEVI float bf2f(bf16_t u) { return __uint_as_float(((unsigned)u) << 16); }
DEVI float silu_f(float x) { return x * __builtin_amdgcn_rcpf(1.f + __expf(-x)); }
DEVI float wave_sum(float v) {
#pragma unroll
    for (int o = 1; o < 64; o <<= 1) v += __shfl_xor(v, o);
    return v;
}
DEVI int row_cond(int row) { return row < MP ? 0 : 1 + ((row - MP) >> 11); }

struct TJob { int in_idx, src_off, K, N, map, row_off, dst_ld; unsigned dst_off; };
__device__ const TJob g_jobs[18] = {
    {12, 0,               1024, 3072, 0, 0, 1024, (unsigned)WS_WCIN},
    {12, 1024 * 3072,     1024, 3072, 0, 0, 1024, (unsigned)(WS_WCIN + 3072ull * 1024 * 2)},
    {14, 0,               1024, 1024, 0, 0, 1024, (unsigned)WS_WCOUT},
    {14, 1024 * 1024,     1024, 1024, 0, 0, 1024, (unsigned)(WS_WCOUT + 1024ull * 1024 * 2)},
    {15, 0,               1024, 1536, 0, 0, 1024, (unsigned)WS_WQKV},
    {18, 0,               1024, 1024, 0, 0, 1024, (unsigned)WS_WAO},
    {19, 0,               1024, 3072, 0, 0, 1024, (unsigned)WS_WGIN},
    {20, 0,               1024, 16,   0, 3072, 1024, (unsigned)WS_WGIN},
    {20, 1024 * 16,       1024, 16,   0, 3088, 1024, (unsigned)WS_WGIN},
    {24, 0,               1024, 1024, 0, 0, 1024, (unsigned)WS_WGO},
    {25, 0,               1024, 5632, 1, 0, 1024, (unsigned)WS_WFIN},
    {25, 1024 * 5632,     1024, 5632, 1, 0, 1024, (unsigned)(WS_WFIN + 1ull * 5632 * 1024 * 2)},
    {25, 2 * 1024 * 5632, 1024, 5632, 1, 0, 1024, (unsigned)(WS_WFIN + 2ull * 5632 * 1024 * 2)},
    {25, 3 * 1024 * 5632, 1024, 5632, 1, 0, 1024, (unsigned)(WS_WFIN + 3ull * 5632 * 1024 * 2)},
    {26, 0,               2816, 1024, 0, 0, 2816, (unsigned)WS_WFOUT},
    {26, 2816 * 1024,     2816, 1024, 0, 0, 2816, (unsigned)(WS_WFOUT + 1ull * 1024 * 2816 * 2)},
    {26, 2 * 2816 * 1024, 2816, 1024, 0, 0, 2816, (unsigned)(WS_WFOUT + 2ull * 1024 * 2816 * 2)},
    {26, 3 * 2816 * 1024, 2816, 1024, 0, 0, 2816, (unsigned)(WS_WFOUT + 3ull * 1024 * 2816 * 2)},
};
constexpr int N_MODJOBS = 192;

DEVI void transpose_item(const float* W, int K, int N, int map, bf16_t* dst, int dst_ld, int row_off, int item, float* tl) {
    const int nb = (N + 63) >> 6;
    const int kb = item / nb, nbi = item - kb * nb, k0 = kb * 64, n0 = nbi * 64;
    const int tid = otid();
    {
        const int c = tid & 63, r = tid >> 6, n = n0 + c;
#pragma unroll
        for (int i = 0; i < 8; ++i) { const int kk = r + 8 * i; tl[kk * 65 + c] = (n < N) ? W[(size_t)(k0 + kk) * N + n] : 0.f; }
    }
    __syncthreads();
    {
        const int kp = tid & 31, nr = tid >> 5;
#pragma unroll
        for (int i = 0; i < 4; ++i) {
            const int nl = nr + 16 * i, n = n0 + nl;
            if (n < N) {
                int np = n;
                if (map == 1) np = (n < DFF) ? (256 * (n >> 7) + (n & 127)) : (256 * ((n - DFF) >> 7) + 128 + ((n - DFF) & 127));
                const float a = tl[(2 * kp) * 65 + nl], b = tl[(2 * kp + 1) * 65 + nl];
                *(unsigned*)(dst + (size_t)(row_off + np) * dst_ld + k0 + 2 * kp) = pk2(a, b);
            }
        }
    }
    __syncthreads();
}

DEVI void mod_job(const Params& p, int job, float* sl) {
    const int third = job % 3, lk = job / 3, kc = lk & 15, l = lk >> 4;
    const int tid = otid();
    if (tid < 192) {
        const int c = tid >> 6, kk = tid & 63, k = kc * 64 + kk;
        const float x = (c == 0) ? inp(7)[k] : inp(2)[(c - 1) * 1024 + k];
        sl[c * 64 + kk] = silu_f(x);
    }
    __syncthreads();
    const int n0 = third * 2048 + tid * 4;
    const float* W = inp(8) + (size_t)l * 1024 * 6144 + (size_t)(kc * 64) * 6144 + n0;
    f32x4 a0 = {0, 0, 0, 0}, a1 = a0, a2 = a0;
#pragma unroll 8
    for (int kk = 0; kk < 64; ++kk) {
        const f32x4 w = *(const f32x4*)(W + (size_t)kk * 6144);
        a0 += w * sl[kk]; a1 += w * sl[64 + kk]; a2 += w * sl[128 + kk];
    }
    float* P = (float*)(p.ws + WS_MODP) + (size_t)((kc * 4 + l) * 3) * 6144 + n0;
    *(f32x4*)(P) = a0; *(f32x4*)(P + 6144) = a1; *(f32x4*)(P + 2 * 6144) = a2;
    __syncthreads();
}

DEVI void phase_prep(const Params& p, unsigned char* smem) {
    float* tl = (float*)smem;
    int total = N_MODJOBS;
    int jstart[19];
#pragma unroll
    for (int j = 0; j < 18; ++j) { jstart[j] = total; total += (g_jobs[j].K >> 6) * ((g_jobs[j].N + 63) >> 6); }
    jstart[18] = total;
    for (int it = obid(); it < total; it += gridDim.x) {
        if (it < N_MODJOBS) { mod_job(p, it, tl); continue; }
        int j = 0;
#pragma unroll
        for (int q = 1; q < 18; ++q) if (it >= jstart[q]) j = q;
        const TJob jb = g_jobs[j];
        transpose_item(inp(__builtin_amdgcn_readfirstlane(jb.in_idx)) + jb.src_off, jb.K, jb.N, jb.map, (bf16_t*)(p.ws + jb.dst_off), jb.dst_ld, jb.row_off, it - jstart[j], tl);
    }
    {
        u32x4* z = (u32x4*)(p.ws + WS_WGIN + 3104ull * 1024 * 2);
        const int n16 = 224 * 1024 * 2 / 16;
        for (int i = obid() * NTHREADS + otid(); i < n16; i += gridDim.x * NTHREADS) z[i] = (u32x4){0, 0, 0, 0};
    }
}

DEVI void phase_modfinal(const Params& p) {
    const float* P = (const float*)(p.ws + WS_MODP);
    float* Mo = (float*)(p.ws + WS_MOD);
    for (int idx = obid() * NTHREADS + otid(); idx < 4 * 3 * 6144; idx += gridDim.x * NTHREADS) {
        const int l = idx / 18432, rem = idx - l * 18432, c = rem / 6144, j = rem - c * 6144;
        float s = inp(9)[l * 6144 + j];
#pragma unroll
        for (int kc = 0; kc < 16; ++kc) s += P[(size_t)((kc * 4 + l) * 3 + c) * 6144 + j];
        Mo[idx] = s;
    }
}

template <int MODE>
DEVI void phase_rows(const Params& p, const float* lng, const float* lnb, const float* modn, int ch_sh, int ch_sc, bool write_out) {
    float* X = (float*)(p.ws + WS_X);
    bf16_t* H = (bf16_t*)(p.ws + WS_H);
    const int lane = otid() & 63;
    const int gw = obid() * 8 + (otid() >> 6), NW = gridDim.x * 8;
    for (int row = gw; row < MTOK; row += NW) {
        const float* src = (MODE == 0) ? (row < MP ? inp(0) + (size_t)row * D : inp(1) + (size_t)(row - MP) * D) : X + (size_t)row * D;
        f32x4 v[4];
#pragma unroll
        for (int j = 0; j < 4; ++j) v[j] = ((const f32x4*)src)[lane + 64 * j];
        if (MODE == 1) {
            float s = 0.f;
#pragma unroll
            for (int j = 0; j < 4; ++j) s += (v[j].x + v[j].y) + (v[j].z + v[j].w);
            const float mean = wave_sum(s) * (1.f / D);
            float s2 = 0.f;
#pragma unroll
            for (int j = 0; j < 4; ++j) { v[j] = v[j] - mean; s2 += (v[j].x * v[j].x + v[j].y * v[j].y) + (v[j].z * v[j].z + v[j].w * v[j].w); }
            const float rstd = rsqrtf(wave_sum(s2) * (1.f / D) + 1e-5f);
#pragma unroll
            for (int j = 0; j < 4; ++j) {
                const f32x4 g = ((const f32x4*)lng)[lane + 64 * j], b = ((const f32x4*)lnb)[lane + 64 * j];
                v[j] = v[j] * rstd * g + b;
            }
        }
#pragma unroll
        for (int j = 0; j < 4; ++j) ((f32x4*)(X + (size_t)row * D))[lane + 64 * j] = v[j];
        if (write_out) {
#pragma unroll
            for (int j = 0; j < 4; ++j) ((f32x4*)(p.out + OUT_Y + (size_t)row * D))[lane + 64 * j] = v[j];
        }
        if (modn) {
            const int cond = row_cond(row);
            const float* sc = modn + cond * 6144 + ch_sc * 1024;
            const float* sh = modn + cond * 6144 + ch_sh * 1024;
#pragma unroll
            for (int j = 0; j < 4; ++j) {
                const f32x4 a = ((const f32x4*)sc)[lane + 64 * j], b = ((const f32x4*)sh)[lane + 64 * j];
                const f32x4 h = v[j] * (a + 1.f) + b;
                u32x2 o; o.x = pk2(h.x, h.y); o.y = pk2(h.z, h.w);
                ((u32x2*)(H + (size_t)row * D))[lane + 64 * j] = o;
            }
        }
    }
}

namespace pg8 {
#define PG8_LAS __attribute__((address_space(3)))
constexpr int BM = 256, BK = 64, HALF = 128, HTB = HALF * BK * 2, STAGE_BYTES = 8 * HTB, NXCD = 8, WGM = 8;
DEVI int lds_byte(int r, int c) { const int st = (r >> 4) * 2 + (c >> 5), rr = r & 15, cc = c & 31, ob = rr * 64 + cc * 2; return st * 1024 + (ob ^ (((ob >> 9) & 1) << 5)); }
DEVI void stage_rc(int b, int& R, int& C) { const int st = b / 1024, sb = b % 1024, swz = sb ^ (((sb >> 9) & 1) << 5); R = (st >> 1) * 16 + swz / 64; C = (st & 1) * 32 + (swz % 64) / 2; }
DEVI int perm32(int rho) { const int n = rho >> 4, i = rho & 15; return 8 * (i >> 2) + 4 * n + (i & 3); }
struct Unit { int pm, pn; };
struct Gemm { const bf16_t* A; const bf16_t* Bt; int M, N, K; };
struct StaticOrder {
    int nM, nN, nwg, G, c;
    DEVI void init(int M, int N, int G_, int c_) { nM = M / BM; nN = N / BM; nwg = nM * nN; G = G_; c = c_; }
    DEVI bool next(int i, Unit& u) const {
        const long L = (long)i * G + c; if (L >= nwg) return false;
        int wgid = (int)L; { const int q = nwg / NXCD, r = nwg % NXCD, xcd = wgid % NXCD, off = wgid / NXCD; wgid = (xcd < r ? xcd * (q + 1) : r * (q + 1) + (xcd - r) * q) + off; }
        const int nig = WGM * nN, gid = wgid / nig, fm = gid * WGM, gsz = (nM - fm) < WGM ? (nM - fm) : WGM;
        u.pm = fm + ((wgid % nig) % gsz); u.pn = (wgid % nig) / gsz; return true;
    }
    DEVI void a_ready(const Unit&) const {}
    DEVI void done(const Unit&) const {}
};
struct EpiStore {
    static constexpr bool PERM = true, AFTER_DRAIN = false;
    bf16_t* O; int ldo;
    DEVI void operator()(const f32x4 (&acc)[2][2][4][2], const Unit& u, int wr, int wc, int fr, int fq) const {
        const int row0 = u.pm * BM + wr * 64 + fr, col0 = u.pn * BM + wc * 32 + 8 * fq;
#pragma unroll
        for (int ai = 0; ai < 2; ++ai)
#pragma unroll
            for (int m = 0; m < 4; ++m) { bf16_t* rowp = O + (size_t)(row0 + ai * HALF + m * 16) * ldo + col0;
#pragma unroll
                for (int bj = 0; bj < 2; ++bj) { const f32x4 v0 = acc[ai][bj][m][0], v1 = acc[ai][bj][m][1];
                    u32x4 w; w.x = pk2(v0[0], v0[1]); w.y = pk2(v0[2], v0[3]); w.z = pk2(v1[0], v1[1]); w.w = pk2(v1[2], v1[3]);
                    *(u32x4*)(rowp + bj * HALF) = w; } }
    }
};
struct EpiSwiglu {
    static constexpr bool PERM = true, AFTER_DRAIN = false;
    bf16_t* O; int ldo;
    DEVI void operator()(const f32x4 (&acc)[2][2][4][2], const Unit& u, int wr, int wc, int fr, int fq) const {
        const int row0 = u.pm * BM + wr * 64 + fr, col0 = u.pn * HALF + wc * 32 + 8 * fq;
#pragma unroll
        for (int ai = 0; ai < 2; ++ai)
#pragma unroll
            for (int m = 0; m < 4; ++m) { bf16_t* rowp = O + (size_t)(row0 + ai * HALF + m * 16) * ldo + col0;
                const f32x4 g0 = acc[ai][0][m][0], g1 = acc[ai][0][m][1], u0 = acc[ai][1][m][0], u1 = acc[ai][1][m][1];
                u32x4 w; w.x = pk2(silu_f(g0[0]) * u0[0], silu_f(g0[1]) * u0[1]); w.y = pk2(silu_f(g0[2]) * u0[2], silu_f(g0[3]) * u0[3]);
                w.z = pk2(silu_f(g1[0]) * u1[0], silu_f(g1[1]) * u1[1]); w.w = pk2(silu_f(g1[2]) * u1[2], silu_f(g1[3]) * u1[3]);
                *(u32x4*)rowp = w; }
    }
};
struct EpiResid {
    static constexpr bool PERM = true, AFTER_DRAIN = false;
    float* X; const float* ga;
    DEVI void operator()(const f32x4 (&acc)[2][2][4][2], const Unit& u, int wr, int wc, int fr, int fq) const {
        const int row0 = u.pm * BM + wr * 64 + fr, col0 = u.pn * BM + wc * 32 + 8 * fq;
        const int cond = u.pm < 16 ? 0 : 1 + ((u.pm - 16) >> 3);
        const float* g = ga + cond * 6144 + col0;
#pragma unroll
        for (int bj = 0; bj < 2; ++bj) {
            const f32x4 g0 = *(const f32x4*)(g + bj * HALF), g1 = *(const f32x4*)(g + bj * HALF + 4);
#pragma unroll
            for (int ai = 0; ai < 2; ++ai)
#pragma unroll
                for (int m = 0; m < 4; ++m) { float* xp = X + (size_t)(row0 + ai * HALF + m * 16) * D + col0 + bj * HALF;
                    const f32x4 x0 = *(const f32x4*)xp, x1 = *(const f32x4*)(xp + 4);
                    *(f32x4*)xp = x0 * ALPHA + g0 * acc[ai][bj][m][0]; *(f32x4*)(xp + 4) = x1 * ALPHA + g1 * acc[ai][bj][m][1]; }
        }
    }
};
template <class Epi, class Sched, bool ALIGN_EPI = false, bool SP2 = false>
__device__ __forceinline__ void gemm_phase(PG8_LAS unsigned char* lds, const Gemm g, const Sched& S, const Epi& E) {
    const int tid = otid(), wid = __builtin_amdgcn_readfirstlane(tid >> 6), lane = tid & 63, wr = wid >> 2, wc = wid & 3, fr = lane & 15, fq = lane >> 4;
    const int K = g.K, nt = K / BK;
    unsigned voffA[2], voffB[2];
#pragma unroll
    for (int i = 0; i < 2; ++i) { int R, C; stage_rc(tid * 16 + i * 8192, R, C); const int Rb = Epi::PERM ? ((R & ~31) + perm32(R & 31)) : R;
        voffA[i] = (unsigned)(R * K + C) * 2u; voffB[i] = (unsigned)(Rb * K + C) * 2u; }
    const size_t kstep = (size_t)(BK * 2);
    const size_t hstep = (size_t)HALF * K * 2;
    const size_t tstep = 2 * hstep;
    const unsigned ldsw = (unsigned)wid * 1024u;
    const int aoff = lds_byte(wr * 64 + fr, fq * 8), boff = lds_byte(wc * 32 + fr, fq * 8);
#define PG8_SA(b, h) (((b) * 2 + (h)) * HTB)
#define PG8_SB(b, h) ((4 + (b) * 2 + (h)) * HTB)
#define PG8_STAGE(bufoff, gbase, voff) do { _Pragma("unroll") for (int _i = 0; _i < 2; ++_i) \
        __builtin_amdgcn_global_load_lds((const unsigned*)((const char*)(gbase) + (voff)[_i]), (PG8_LAS unsigned*)(lds + (bufoff) + ldsw + _i * 8192), 16, 0, 0); } while (0)
#define PG8_LDA(dst, b, h) do { _Pragma("unroll") for (int m = 0; m < 4; ++m) _Pragma("unroll") for (int k = 0; k < 2; ++k) dst[m][k] = *(const PG8_LAS bf16x8*)(lds + PG8_SA(b, h) + aoff + m * 2048 + k * 1024); } while (0)
#define PG8_LDB(dst, b, h) do { _Pragma("unroll") for (int n = 0; n < 2; ++n) _Pragma("unroll") for (int k = 0; k < 2; ++k) dst[n][k] = *(const PG8_LAS bf16x8*)(lds + PG8_SB(b, h) + boff + n * 2048 + k * 1024); } while (0)
#define PG8_MMA(ai, bj, At, Bt) do { __builtin_amdgcn_s_setprio(1); _Pragma("unroll") for (int m = 0; m < 4; ++m) _Pragma("unroll") for (int n = 0; n < 2; ++n) _Pragma("unroll") for (int k = 0; k < 2; ++k) \
        acc[ai][bj][m][n] = __builtin_amdgcn_mfma_f32_16x16x32_bf16(Bt[n][k], At[m][k], acc[ai][bj][m][n], 0, 0, 0); __builtin_amdgcn_s_setprio(0); } while (0)
#define PG8_WAIT_V(n) asm volatile("s_waitcnt vmcnt(" #n ")" ::: "memory")
#define PG8_WAIT_L(n) asm volatile("s_waitcnt lgkmcnt(" #n ")" ::: "memory")
#define PG8_BAR __builtin_amdgcn_s_barrier()
#define PG8_SCHED __builtin_amdgcn_sched_barrier(0)
    Unit cur, nxt; int ui = 0;
    if (!S.next(0, cur)) return;
    f32x4 acc[2][2][4][2];
#pragma unroll
    for (int a = 0; a < 2; ++a)
#pragma unroll
        for (int b = 0; b < 2; ++b)
#pragma unroll
            for (int m = 0; m < 4; ++m)
#pragma unroll
                for (int n = 0; n < 2; ++n) acc[a][b][m][n] = (f32x4){0.f, 0.f, 0.f, 0.f};
    bf16x8 At[4][2], B0[2][2], B1[2][2];
    const char* cA = (const char*)g.A + (size_t)cur.pm * tstep; const char* cB = (const char*)g.Bt + (size_t)cur.pn * tstep;
    S.a_ready(cur);
    if constexpr (SP2) {
        PG8_STAGE(PG8_SB(0, 0), cB, voffB); PG8_STAGE(PG8_SB(0, 1), cB + hstep, voffB); PG8_STAGE(PG8_SA(0, 0), cA, voffA); PG8_STAGE(PG8_SA(0, 1), cA + hstep, voffA);
        if (wr == 1) PG8_BAR;
        PG8_WAIT_V(2); PG8_BAR;
        PG8_STAGE(PG8_SB(1, 0), cB + kstep, voffB); PG8_STAGE(PG8_SA(1, 0), cA + kstep, voffA); PG8_STAGE(PG8_SB(1, 1), cB + hstep + kstep, voffB);
        PG8_WAIT_V(6); PG8_BAR;
    } else {
        PG8_STAGE(PG8_SB(0, 0), cB, voffB); PG8_STAGE(PG8_SA(0, 0), cA, voffA); PG8_STAGE(PG8_SB(0, 1), cB + hstep, voffB); PG8_STAGE(PG8_SA(0, 1), cA + hstep, voffA);
        if (wr == 1) PG8_BAR;
        PG8_WAIT_V(4); PG8_BAR;
        PG8_STAGE(PG8_SB(1, 0), cB + kstep, voffB); PG8_STAGE(PG8_SA(1, 0), cA + kstep, voffA); PG8_STAGE(PG8_SB(1, 1), cB + hstep + kstep, voffB);
        PG8_WAIT_V(6); PG8_BAR;
    }
    for (;;) {
        const bool has_next = S.next(ui + 1, nxt);
        const char* nA = has_next ? (const char*)g.A + (size_t)nxt.pm * tstep : cA; const char* nB = has_next ? (const char*)g.Bt + (size_t)nxt.pn * tstep : cB;
        for (int t = 0; t < nt; t += 2) {
            const bool last = (t == nt - 2);
            const char* a1 = cA + (size_t)(t + 1) * kstep;
            const char* a2 = last ? nA : cA + (size_t)(t + 2) * kstep; const char* b2 = last ? nB : cB + (size_t)(t + 2) * kstep;
            const char* a3 = a2 + kstep; const char* b3 = b2 + kstep;
            if (last && has_next) S.a_ready(nxt);
            if constexpr (SP2) {
            PG8_LDB(B0, 0, 0); PG8_LDB(B1, 0, 1); PG8_SCHED; PG8_LDA(At, 0, 0); PG8_STAGE(PG8_SA(1, 1), a1 + hstep, voffA);
            PG8_WAIT_V(8); PG8_WAIT_L(0); PG8_BAR; PG8_MMA(0, 0, At, B0); PG8_MMA(0, 1, At, B1); PG8_BAR; PG8_SCHED;
            PG8_LDA(At, 0, 1); PG8_STAGE(PG8_SB(0, 0), b2, voffB); PG8_STAGE(PG8_SB(0, 1), b2 + hstep, voffB); PG8_STAGE(PG8_SA(0, 0), a2, voffA);
            PG8_WAIT_V(8); PG8_WAIT_L(0); PG8_BAR; PG8_MMA(1, 0, At, B0); PG8_MMA(1, 1, At, B1); PG8_BAR; PG8_SCHED;
            PG8_LDB(B0, 1, 0); PG8_LDB(B1, 1, 1); PG8_SCHED; PG8_LDA(At, 1, 0); PG8_STAGE(PG8_SA(0, 1), a2 + hstep, voffA);
            PG8_WAIT_V(8); PG8_WAIT_L(0); PG8_BAR; PG8_MMA(0, 0, At, B0); PG8_MMA(0, 1, At, B1); PG8_BAR; PG8_SCHED;
            PG8_LDA(At, 1, 1); PG8_STAGE(PG8_SB(1, 0), b3, voffB); PG8_STAGE(PG8_SB(1, 1), b3 + hstep, voffB); PG8_STAGE(PG8_SA(1, 0), a3, voffA);
            PG8_WAIT_V(8); PG8_WAIT_L(0); PG8_BAR; PG8_MMA(1, 0, At, B0); PG8_MMA(1, 1, At, B1); PG8_BAR; PG8_SCHED;
            } else {
            PG8_LDB(B0, 0, 0); PG8_SCHED; PG8_LDA(At, 0, 0); PG8_STAGE(PG8_SA(1, 1), a1 + hstep, voffA);
            PG8_WAIT_L(8); PG8_BAR; PG8_WAIT_L(0); PG8_MMA(0, 0, At, B0); PG8_BAR; PG8_SCHED;
            PG8_LDB(B1, 0, 1); PG8_STAGE(PG8_SB(0, 0), b2, voffB);
            PG8_BAR; PG8_WAIT_L(0); PG8_MMA(0, 1, At, B1); PG8_BAR;
            PG8_LDA(At, 0, 1); PG8_STAGE(PG8_SA(0, 0), a2, voffA);
            PG8_BAR; PG8_WAIT_L(0); PG8_MMA(1, 0, At, B0); PG8_BAR; PG8_SCHED;
            PG8_STAGE(PG8_SB(0, 1), b2 + hstep, voffB);
            PG8_WAIT_V(6); PG8_BAR; PG8_MMA(1, 1, At, B1); PG8_BAR;
            PG8_LDB(B0, 1, 0); PG8_SCHED; PG8_LDA(At, 1, 0); PG8_STAGE(PG8_SA(0, 1), a2 + hstep, voffA);
            PG8_WAIT_L(8); PG8_BAR; PG8_WAIT_L(0); PG8_MMA(0, 0, At, B0); PG8_BAR; PG8_SCHED;
            PG8_LDB(B1, 1, 1); PG8_STAGE(PG8_SB(1, 0), b3, voffB);
            PG8_BAR; PG8_WAIT_L(0); PG8_MMA(0, 1, At, B1); PG8_BAR;
            PG8_LDA(At, 1, 1); PG8_STAGE(PG8_SA(1, 0), a3, voffA);
            PG8_BAR; PG8_WAIT_L(0); PG8_MMA(1, 0, At, B0); PG8_BAR; PG8_SCHED;
            PG8_STAGE(PG8_SB(1, 1), b3 + hstep, voffB);
            PG8_WAIT_V(6); PG8_BAR; PG8_MMA(1, 1, At, B1); PG8_BAR;
            }
        }
        if constexpr (ALIGN_EPI) { if (wr == 0) PG8_BAR; }
        if constexpr (!Epi::AFTER_DRAIN) { E(acc, cur, wr, wc, fr, fq); S.done(cur); }
        if (!has_next) break;
#pragma unroll
        for (int a = 0; a < 2; ++a)
#pragma unroll
            for (int b = 0; b < 2; ++b)
#pragma unroll
                for (int m = 0; m < 4; ++m)
#pragma unroll
                    for (int n = 0; n < 2; ++n) acc[a][b][m][n] = (f32x4){0.f, 0.f, 0.f, 0.f};
        cur = nxt; cA = nA; cB = nB; ++ui;
        if constexpr (ALIGN_EPI) { if (wr == 1) PG8_BAR; }
    }
    PG8_WAIT_V(0);
    if constexpr (!ALIGN_EPI) { if (wr == 0) PG8_BAR; }
    PG8_BAR;
    if constexpr (Epi::AFTER_DRAIN) { E.fused(acc, cur, wr, wc, fr, fq, lds, wid, lane); S.done(cur); }
#undef PG8_SA
#undef PG8_SB
#undef PG8_STAGE
#undef PG8_LDA
#undef PG8_LDB
#undef PG8_MMA
#undef PG8_WAIT_V
#undef PG8_WAIT_L
#undef PG8_BAR
#undef PG8_SCHED
}
}

DEVI void phase_conv(const Params& p, int j) {
    const bf16_t* U = (const bf16_t*)(p.ws + WS_BIG);
    bf16_t* Z = (bf16_t*)(p.ws + WS_Z);
    const float* cw = inp(13) + (size_t)j * 3 * D;
    for (int it = obid() * NTHREADS + otid(); it < MTOK * 128; it += gridDim.x * NTHREADS) {
        const int row = it >> 7, c8 = (it & 127) * 8;
        int s, Ls; if (row < MP) { s = row & 255; Ls = 256; } else { s = (row - MP) & 2047; Ls = 2048; }
        const bf16_t* ur = U + (size_t)row * 3072;
        const u32x4 bg = *(const u32x4*)(ur + c8);
        const u32x4 c0 = *(const u32x4*)(ur + 1024 + c8), u0 = *(const u32x4*)(ur + 2048 + c8);
        u32x4 cp = {0, 0, 0, 0}, up = cp, cn = cp, un = cp;
        if (s > 0) { cp = *(const u32x4*)(ur - 3072 + 1024 + c8); up = *(const u32x4*)(ur - 3072 + 2048 + c8); }
        if (s < Ls - 1) { cn = *(const u32x4*)(ur + 3072 + 1024 + c8); un = *(const u32x4*)(ur + 3072 + 2048 + c8); }
        float w0[8], w1[8], w2[8];
#pragma unroll
        for (int i = 0; i < 2; ++i) {
            const f32x4 a = *(const f32x4*)(cw + c8 + 4 * i), b = *(const f32x4*)(cw + D + c8 + 4 * i), c = *(const f32x4*)(cw + 2 * D + c8 + 4 * i);
#pragma unroll
            for (int q = 0; q < 4; ++q) { w0[4 * i + q] = a[q]; w1[4 * i + q] = b[q]; w2[4 * i + q] = c[q]; }
        }
        u32x4 o;
#pragma unroll
        for (int q = 0; q < 4; ++q) {
            const float vlo = bflo(bg[q]) * (w0[2 * q] * bflo(cp[q]) * bflo(up[q]) + w1[2 * q] * bflo(c0[q]) * bflo(u0[q]) + w2[2 * q] * bflo(cn[q]) * bflo(un[q]));
            const float vhi = bfhi(bg[q]) * (w0[2 * q + 1] * bfhi(cp[q]) * bfhi(up[q]) + w1[2 * q + 1] * bfhi(c0[q]) * bfhi(u0[q]) + w2[2 * q + 1] * bfhi(cn[q]) * bfhi(un[q]));
            o[q] = pk2(vlo, vhi);
        }
        *(u32x4*)(Z + (size_t)row * D + c8) = o;
    }
}

DEVI void phase_attn_prep(const Params& p, unsigned char* smem) {
    const bf16_t* QKV = (const bf16_t*)(p.ws + WS_BIG);
    bf16_t* Qb = (bf16_t*)(p.ws + WS_AQ);
    bf16_t* KP = (bf16_t*)(p.ws + WS_AKP);
    bf16_t* KS = (bf16_t*)(p.ws + WS_AKS);
    bf16_t* VP = (bf16_t*)(p.ws + WS_AVP);
    bf16_t* VS = (bf16_t*)(p.ws + WS_AVS);
    const float* qg = inp(16); const float* kg = inp(17);
    const int lane = otid() & 63;
    const int gw = obid() * 8 + (otid() >> 6), NW = gridDim.x * 8;
    const int axis = lane >> 5, f = lane & 31;
    const int i1 = axis * 64 + f, i2 = i1 + 32;
    const float freq = exp2f(-(float)f * (13.287712379549449f / 32.f));
    for (int it = gw; it < MTOK * 10; it += NW) {
        const int row = it / 10, slot = it - row * 10;
        const bf16_t* src = QKV + (size_t)row * 1536 + slot * 128;
        float x1 = bf2f(src[i1]), x2 = bf2f(src[i2]);
        const float ss = wave_sum(x1 * x1 + x2 * x2);
        const float rstd = rsqrtf(ss * (1.f / 128.f) + 1e-6f);
        const float* g = slot < 8 ? qg : kg;
        x1 = x1 * rstd * g[i1]; x2 = x2 * rstd * g[i2];
        if (row >= MP) {
            const int s = (row - MP) & 2047;
            const float pos = axis == 0 ? (float)(s >> 6) : (float)(s & 63);
            float sn, cs; sincosf(pos * freq, &sn, &cs);
            const float y1 = x1 * cs - x2 * sn, y2 = x2 * cs + x1 * sn;
            x1 = y1; x2 = y2;
        }
        if (slot < 8) {
            const float sc = 0.08838834764831845f * 1.4426950408889634f;
            bf16_t* d = Qb + (size_t)row * D + slot * 128;
            d[i1] = (bf16_t)(pk2(x1 * sc, 0.f) & 0xffff); d[i2] = (bf16_t)(pk2(x2 * sc, 0.f) & 0xffff);
        } else {
            const int kvh = slot - 8;
            bf16_t* d;
            if (row < MP) {
                d = KP + (size_t)row * 256 + kvh * 128;
                float* o = p.out + OUT_CK + (size_t)row * 256 + kvh * 128;
                o[i1] = x1; o[i2] = x2;
            } else {
                const int b = (row - MP) >> 11, s = (row - MP) & 2047;
                d = KS + ((size_t)b * 2304 + 256 + s) * 256 + kvh * 128;
            }
            d[i1] = (bf16_t)(pk2(x1, 0.f) & 0xffff); d[i2] = (bf16_t)(pk2(x2, 0.f) & 0xffff);
        }
    }
    for (int it = obid() * NTHREADS + otid(); it < 2 * 256 * 256 / 4; it += gridDim.x * NTHREADS) {
        const int e = it * 4, b = e >> 16, r = e & 65535;
        const f32x4 v = *(const f32x4*)(inp(3) + e);
        u32x2 o; o.x = pk2(v.x, v.y); o.y = pk2(v.z, v.w);
        *(u32x2*)(KS + (size_t)b * 2304 * 256 + r) = o;
    }
    bf16_t* vl = (bf16_t*)smem;
    for (int job = obid(); job < 64 + 72; job += gridDim.x) {
        int nkeys, kb; bf16_t* dst; const bf16_t* srcb = nullptr; const float* srcf = nullptr; float* outv = nullptr;
        if (job < 64) { const int b = job >> 2; kb = job & 3; nkeys = 256; dst = VP + (size_t)b * 2 * 128 * 256;
            srcb = QKV + (size_t)(b * 256 + kb * 64) * 1536 + 1280; outv = p.out + OUT_CV + (size_t)(b * 256 + kb * 64) * 256; }
        else { const int jj = job - 64, b = jj / 36; kb = jj - b * 36; nkeys = 2304; dst = VS + (size_t)b * 2 * 128 * 2304;
            if (kb < 4) srcf = inp(4) + (size_t)b * 65536 + (size_t)kb * 64 * 256;
            else srcb = QKV + (size_t)(MP + b * 2048 + (kb - 4) * 64) * 1536 + 1280; }
        for (int c = otid(); c < 64 * 32; c += NTHREADS) {
            const int key = c >> 5, c8 = (c & 31) * 8;
            u32x4 v;
            if (srcb) v = *(const u32x4*)(srcb + (size_t)key * 1536 + c8);
            else { const f32x4 a = *(const f32x4*)(srcf + key * 256 + c8), b2 = *(const f32x4*)(srcf + key * 256 + c8 + 4);
                v.x = pk2(a.x, a.y); v.y = pk2(a.z, a.w); v.z = pk2(b2.x, b2.y); v.w = pk2(b2.z, b2.w); }
            *(u32x4*)(vl + key * 264 + c8) = v;
            if (outv) {
                f32x4 a = {bflo(v.x), bfhi(v.x), bflo(v.y), bfhi(v.y)}, b2 = {bflo(v.z), bfhi(v.z), bflo(v.w), bfhi(v.w)};
                *(f32x4*)(outv + key * 256 + c8) = a; *(f32x4*)(outv + key * 256 + c8 + 4) = b2;
            }
        }
        __syncthreads();
        {
            const int rowv = otid() >> 1, half = otid() & 1;
            bf16_t* drow = dst + (size_t)rowv * nkeys + kb * 64 + half * 32;
#pragma unroll
            for (int q = 0; q < 4; ++q) {
                unsigned w[4];
#pragma unroll
                for (int e = 0; e < 4; ++e) {
                    const int k0 = half * 32 + q * 8 + e * 2;
                    w[e] = (unsigned)vl[k0 * 264 + rowv] | ((unsigned)vl[(k0 + 1) * 264 + rowv] << 16);
                }
                *(u32x4*)(drow + q * 8) = (u32x4){w[0], w[1], w[2], w[3]};
            }
        }
        __syncthreads();
    }
}

constexpr int KSTR = 272, VSTR = 144;
constexpr int ATT_KB = 64 * KSTR, ATT_VB = 128 * VSTR, ATT_BUF = ATT_KB + ATT_VB;
DEVI void phase_attn(const Params& p, unsigned char* smem) {
    const bf16_t* Qb = (const bf16_t*)(p.ws + WS_AQ);
    bf16_t* Z = (bf16_t*)(p.ws + WS_Z);
    const int tid = otid(), wave = tid >> 6, lane = tid & 63, fr = lane & 15, fq = lane >> 4;
    for (int u = obid(); u < 512; u += gridDim.x) {
        int h, nkeys, rowbase; const bf16_t* Kbase; const bf16_t* Vbase;
        if (u < 256) { const int b = u >> 7, qb = u & 15; h = (u >> 4) & 7; nkeys = 2304; rowbase = MP + b * 2048 + qb * 128;
            Kbase = (const bf16_t*)(p.ws + WS_AKS) + (size_t)b * 2304 * 256 + (h >> 2) * 128;
            Vbase = (const bf16_t*)(p.ws + WS_AVS) + (size_t)(b * 2 + (h >> 2)) * 128 * 2304; }
        else { const int v = u - 256, b = v >> 4, qb = v & 1; h = (v >> 1) & 7; nkeys = 256; rowbase = b * 256 + qb * 128;
            Kbase = (const bf16_t*)(p.ws + WS_AKP) + (size_t)b * 256 * 256 + (h >> 2) * 128;
            Vbase = (const bf16_t*)(p.ws + WS_AVP) + (size_t)(b * 2 + (h >> 2)) * 128 * 256; }
        const int ntiles = nkeys >> 6;
        bf16x8 qf[4];
        { const bf16_t* qp = Qb + (size_t)(rowbase + wave * 16 + fr) * D + h * 128 + fq * 8;
#pragma unroll
          for (int ks = 0; ks < 4; ++ks) qf[ks] = *(const bf16x8*)(qp + ks * 32); }
        f32x4 o[8];
#pragma unroll
        for (int dt = 0; dt < 8; ++dt) o[dt] = (f32x4){0, 0, 0, 0};
        float mrun = -1e30f, lsum = 0.f;
        const int kr0 = tid >> 4, kc0 = tid & 15;
        const int vr0 = tid >> 3, vc0 = tid & 7;
        u32x4 kreg[2], vreg[2];
#define ATT_LOAD(t) do { \
        kreg[0] = *(const u32x4*)(Kbase + (size_t)((t) * 64 + kr0) * 256 + kc0 * 8); \
        kreg[1] = *(const u32x4*)(Kbase + (size_t)((t) * 64 + kr0 + 32) * 256 + kc0 * 8); \
        vreg[0] = *(const u32x4*)(Vbase + (size_t)vr0 * nkeys + (t) * 64 + vc0 * 8); \
        vreg[1] = *(const u32x4*)(Vbase + (size_t)(vr0 + 64) * nkeys + (t) * 64 + vc0 * 8); } while (0)
#define ATT_STORE(buf) do { unsigned char* kb_ = smem + (buf) * ATT_BUF; unsigned char* vb_ = kb_ + ATT_KB; \
        *(u32x4*)(kb_ + kr0 * KSTR + kc0 * 16) = kreg[0]; *(u32x4*)(kb_ + (kr0 + 32) * KSTR + kc0 * 16) = kreg[1]; \
        *(u32x4*)(vb_ + vr0 * VSTR + vc0 * 16) = vreg[0]; *(u32x4*)(vb_ + (vr0 + 64) * VSTR + vc0 * 16) = vreg[1]; } while (0)
        ATT_LOAD(0); ATT_STORE(0);
        __syncthreads();
        for (int t = 0; t < ntiles; ++t) {
            if (t + 1 < ntiles) ATT_LOAD(t + 1);
            const unsigned char* kb = smem + (t & 1) * ATT_BUF; const unsigned char* vb = kb + ATT_KB;
            f32x4 s[4];
#pragma unroll
            for (int kt = 0; kt < 4; ++kt) {
                s[kt] = (f32x4){0, 0, 0, 0};
#pragma unroll
                for (int ks = 0; ks < 4; ++ks) {
                    const bf16x8 kf = *(const bf16x8*)(kb + (kt * 16 + fr) * KSTR + (ks * 32 + fq * 8) * 2);
                    s[kt] = __builtin_amdgcn_mfma_f32_16x16x32_bf16(kf, qf[ks], s[kt], 0, 0, 0);
                }
            }
            float mx = -1e30f;
#pragma unroll
            for (int kt = 0; kt < 4; ++kt) mx = fmaxf(mx, fmaxf(fmaxf(s[kt].x, s[kt].y), fmaxf(s[kt].z, s[kt].w)));
            mx = fmaxf(mx, __shfl_xor(mx, 16)); mx = fmaxf(mx, __shfl_xor(mx, 32));
            const float mnew = fmaxf(mrun, mx);
            const float alpha = exp2f(mrun - mnew);
            mrun = mnew;
            float ps = 0.f;
#pragma unroll
            for (int kt = 0; kt < 4; ++kt) {
                s[kt].x = exp2f(s[kt].x - mnew); s[kt].y = exp2f(s[kt].y - mnew); s[kt].z = exp2f(s[kt].z - mnew); s[kt].w = exp2f(s[kt].w - mnew);
                ps += (s[kt].x + s[kt].y) + (s[kt].z + s[kt].w);
            }
            lsum = lsum * alpha + ps;
#pragma unroll
            for (int dt = 0; dt < 8; ++dt) o[dt] = o[dt] * alpha;
#pragma unroll
            for (int k2 = 0; k2 < 2; ++k2) {
                u32x4 pw; pw.x = pk2(s[2 * k2].x, s[2 * k2].y); pw.y = pk2(s[2 * k2].z, s[2 * k2].w);
                pw.z = pk2(s[2 * k2 + 1].x, s[2 * k2 + 1].y); pw.w = pk2(s[2 * k2 + 1].z, s[2 * k2 + 1].w);
                const bf16x8 pf = __builtin_bit_cast(bf16x8, pw);
#pragma unroll
                for (int dt = 0; dt < 8; ++dt) {
                    const unsigned char* vp = vb + (dt * 16 + fr) * VSTR + (k2 * 32 + fq * 4) * 2;
                    const u32x2 va = *(const u32x2*)vp, vc = *(const u32x2*)(vp + 32);
                    const u32x4 vw = {va.x, va.y, vc.x, vc.y};
                    o[dt] = __builtin_amdgcn_mfma_f32_16x16x32_bf16(__builtin_bit_cast(bf16x8, vw), pf, o[dt], 0, 0, 0);
                }
            }
            if (t + 1 < ntiles) ATT_STORE((t + 1) & 1);
            __syncthreads();
        }
        lsum += __shfl_xor(lsum, 16); lsum += __shfl_xor(lsum, 32);
        const float inv = 1.f / lsum;
        bf16_t* zp = Z + (size_t)(rowbase + wave * 16 + fr) * D + h * 128 + fq * 4;
#pragma unroll
        for (int dt = 0; dt < 8; ++dt) {
            u32x2 w; w.x = pk2(o[dt].x * inv, o[dt].y * inv); w.y = pk2(o[dt].z * inv, o[dt].w * inv);
            *(u32x2*)(zp + dt * 16) = w;
        }
#undef ATT_LOAD
#undef ATT_STORE
    }
}

constexpr int GLD = 3328;
constexpr int G_R1 = 65536;
constexpr int QK_STR = 136;
constexpr int T_STR = 72;
DEVI void phase_gla_a(const Params& p, unsigned char* smem) {
    const bf16_t* BIGb = (const bf16_t*)(p.ws + WS_BIG);
    bf16_t* GQ = (bf16_t*)(p.ws + WS_GQ);
    bf16_t* GA = (bf16_t*)(p.ws + WS_GA);
    float* GG = (float*)(p.ws + WS_GG);
    bf16_t* GU = (bf16_t*)(p.ws + WS_GU);
    bf16_t* GVT = (bf16_t*)(p.ws + WS_GVT);
    float* bc = (float*)smem;
    unsigned char* r1 = smem + G_R1;
    const int tid = otid(), wave = tid >> 6, lane = tid & 63, fr = lane & 15, fq = lane >> 4;
    for (int unit = obid(); unit < 512; unit += gridDim.x) {
        const int c = unit >> 2, h = unit & 3, r0 = c * 64;
        float* rl = (float*)r1;
        float* w2l = rl + 64 * 33;
        float* bl = w2l + 2 * 16 * 128;
        for (int i = tid; i < 64 * 32; i += NTHREADS) { const int t = i >> 5, q = i & 31; rl[t * 33 + q] = bf2f(BIGb[(size_t)(r0 + t) * GLD + 3072 + q]); }
        for (int i = tid; i < 2 * 16 * 128; i += NTHREADS) { const int dir = i >> 11, rk = (i >> 7) & 15, d = i & 127; w2l[i] = inp(21)[(size_t)(dir * 16 + rk) * 512 + h * 128 + d]; }
        if (tid < 256) { const int dir = tid >> 7, d = tid & 127; bl[tid] = inp(22)[dir * 512 + h * 128 + d]; }
        __syncthreads();
        for (int i = tid; i < 2 * 64 * 128; i += NTHREADS) {
            const int dir = i >> 13, t = (i >> 7) & 63, d = i & 127;
            float z = bl[dir * 128 + d];
#pragma unroll
            for (int q = 0; q < 16; ++q) z += rl[t * 33 + dir * 16 + q] * w2l[(dir * 16 + q) * 128 + d];
            const float ls = fminf(z, 0.f) - log1pf(__expf(-fabsf(z)));
            bc[i] = ls * (1.f / 16.f);
        }
        __syncthreads();
        if (tid < 256) {
            const int dir = tid >> 7, d = tid & 127;
            float run = 0.f;
            if (dir == 0) { for (int t = 0; t < 64; ++t) { run += bc[t * 128 + d]; bc[t * 128 + d] = run; } }
            else { for (int t = 63; t >= 0; --t) { run += bc[8192 + t * 128 + d]; bc[8192 + t * 128 + d] = run; } }
        }
        __syncthreads();
        bf16_t* qk = (bf16_t*)r1;
        for (int i = tid; i < 64 * 16; i += NTHREADS) {
            const int t = i >> 4, d8 = (i & 15) * 8;
            const u32x4 qv = *(const u32x4*)(BIGb + (size_t)(r0 + t) * GLD + h * 128 + d8);
            const u32x4 kv = *(const u32x4*)(BIGb + (size_t)(r0 + t) * GLD + 512 + h * 128 + d8);
            u32x4 oqf, oqb, okf, okb;
#pragma unroll
            for (int q = 0; q < 4; ++q) {
                const float bf0 = bc[t * 128 + d8 + 2 * q], bf1 = bc[t * 128 + d8 + 2 * q + 1];
                const float bb0 = bc[8192 + t * 128 + d8 + 2 * q], bb1 = bc[8192 + t * 128 + d8 + 2 * q + 1];
                const float q0 = bflo(qv[q]) * 0.08838834764831845f, q1 = bfhi(qv[q]) * 0.08838834764831845f;
                const float k0 = bflo(kv[q]), k1 = bfhi(kv[q]);
                oqf[q] = pk2(q0 * __expf(bf0), q1 * __expf(bf1));
                oqb[q] = pk2(q0 * __expf(bb0), q1 * __expf(bb1));
                okf[q] = pk2(k0 * __expf(-bf0), k1 * __expf(-bf1));
                okb[q] = pk2(k0 * __expf(-bb0), k1 * __expf(-bb1));
            }
            *(u32x4*)(qk + (0 * 64 + t) * QK_STR + d8) = oqf;
            *(u32x4*)(qk + (1 * 64 + t) * QK_STR + d8) = oqb;
            *(u32x4*)(qk + (2 * 64 + t) * QK_STR + d8) = okf;
            *(u32x4*)(qk + (3 * 64 + t) * QK_STR + d8) = okb;
            *(u32x4*)(GQ + (size_t)(r0 + t) * 512 + h * 128 + d8) = oqf;
            *(u32x4*)(GQ + (size_t)(MTOK + r0 + t) * 512 + h * 128 + d8) = oqb;
        }
        if (tid < 256) { const int dir = tid >> 7, d = tid & 127;
            GG[(size_t)(unit * 2 + dir) * 128 + d] = __expf(dir == 0 ? bc[63 * 128 + d] : bc[8192 + d]); }
        __syncthreads();
        {
            const int tr = wave & 3;
#pragma unroll
            for (int cc = 0; cc < 2; ++cc) {
                const int tc = (wave >> 2) * 2 + cc;
                f32x4 af = {0, 0, 0, 0}, ab = {0, 0, 0, 0};
#pragma unroll
                for (int ks = 0; ks < 4; ++ks) {
                    const bf16x8 qf_ = *(const bf16x8*)(qk + (0 * 64 + tr * 16 + fr) * QK_STR + ks * 32 + fq * 8);
                    const bf16x8 qb_ = *(const bf16x8*)(qk + (1 * 64 + tr * 16 + fr) * QK_STR + ks * 32 + fq * 8);
                    const bf16x8 kf_ = *(const bf16x8*)(qk + (2 * 64 + tc * 16 + fr) * QK_STR + ks * 32 + fq * 8);
                    const bf16x8 kb_ = *(const bf16x8*)(qk + (3 * 64 + tc * 16 + fr) * QK_STR + ks * 32 + fq * 8);
                    af = __builtin_amdgcn_mfma_f32_16x16x32_bf16(kf_, qf_, af, 0, 0, 0);
                    ab = __builtin_amdgcn_mfma_f32_16x16x32_bf16(kb_, qb_, ab, 0, 0, 0);
                }
                const int t = tr * 16 + fr, s0 = tc * 16 + fq * 4;
                float a[4];
#pragma unroll
                for (int j = 0; j < 4; ++j) { const int s = s0 + j; a[j] = (t >= s ? af[j] : 0.f) + (s >= t ? ab[j] : 0.f); }
                u32x2 w; w.x = pk2(a[0], a[1]); w.y = pk2(a[2], a[3]);
                *(u32x2*)(GA + ((size_t)unit * 64 + t) * 64 + s0) = w;
            }
        }
        __syncthreads();
        bf16_t* khT = (bf16_t*)r1;
        bf16_t* vT = khT + 2 * 128 * T_STR;
        for (int i = tid; i < 64 * 16; i += NTHREADS) {
            const int s = i & 63, d8 = (i >> 6) * 8;
            const u32x4 kv = *(const u32x4*)(BIGb + (size_t)(r0 + s) * GLD + 512 + h * 128 + d8);
#pragma unroll
            for (int q = 0; q < 8; ++q) {
                const int d = d8 + q;
                const float k = (q & 1) ? bfhi(kv[q >> 1]) : bflo(kv[q >> 1]);
                const float ef = __expf(bc[63 * 128 + d] - bc[s * 128 + d]);
                const float eb = __expf(bc[8192 + d] - bc[8192 + s * 128 + d]);
                khT[(0 * 128 + d) * T_STR + s] = (bf16_t)(pk2(k * ef, 0.f) & 0xffff);
                khT[(1 * 128 + d) * T_STR + s] = (bf16_t)(pk2(k * eb, 0.f) & 0xffff);
            }
        }
        for (int i = tid; i < 64 * 32; i += NTHREADS) {
            const int s = i & 63, e8 = (i >> 6) * 8;
            const u32x4 vv = *(const u32x4*)(BIGb + (size_t)(r0 + s) * GLD + 1024 + h * 256 + e8);
#pragma unroll
            for (int q = 0; q < 4; ++q) { vT[(e8 + 2 * q) * T_STR + s] = (bf16_t)(vv[q] & 0xffff); vT[(e8 + 2 * q + 1) * T_STR + s] = (bf16_t)(vv[q] >> 16); }
        }
        __syncthreads();
        for (int i = tid; i < 256 * 8; i += NTHREADS) {
            const int e = i >> 3, cch = i & 7;
            *(u32x4*)(GVT + ((size_t)unit * 256 + e) * 64 + cch * 8) = *(const u32x4*)(vT + e * T_STR + cch * 8);
        }
        {
            const int dir = wave >> 2;
            bf16_t* Uo = GU + (size_t)(unit * 2 + dir) * 256 * 128;
#pragma unroll 1
            for (int eh = 0; eh < 2; ++eh) {
                f32x4 acc[2][8];
#pragma unroll
                for (int a = 0; a < 2; ++a)
#pragma unroll
                    for (int b = 0; b < 8; ++b) acc[a][b] = (f32x4){0, 0, 0, 0};
#pragma unroll
                for (int ks = 0; ks < 2; ++ks) {
                    bf16x8 af[2];
#pragma unroll
                    for (int a = 0; a < 2; ++a) af[a] = *(const bf16x8*)(khT + (dir * 128 + ((wave & 3) * 2 + a) * 16 + fr) * T_STR + ks * 32 + fq * 8);
#pragma unroll
                    for (int b = 0; b < 8; ++b) {
                        const bf16x8 bfv = *(const bf16x8*)(vT + ((eh * 8 + b) * 16 + fr) * T_STR + ks * 32 + fq * 8);
#pragma unroll
                        for (int a = 0; a < 2; ++a) acc[a][b] = __builtin_amdgcn_mfma_f32_16x16x32_bf16(af[a], bfv, acc[a][b], 0, 0, 0);
                    }
                }
#pragma unroll
                for (int a = 0; a < 2; ++a)
#pragma unroll
                    for (int b = 0; b < 8; ++b) {
                        const int d0 = ((wave & 3) * 2 + a) * 16 + fq * 4, e = (eh * 8 + b) * 16 + fr;
                        u32x2 w; w.x = pk2(acc[a][b].x, acc[a][b].y); w.y = pk2(acc[a][b].z, acc[a][b].w);
                        *(u32x2*)(Uo + (size_t)e * 128 + d0) = w;
                    }
            }
        }
        __syncthreads();
    }
}

DEVI void phase_gla_scan(const Params& p) {
    bf16_t* GU = (bf16_t*)(p.ws + WS_GU);
    const float* GG = (const float*)(p.ws + WS_GG);
    const int T = gridDim.x * NTHREADS;
    for (int id = obid() * NTHREADS + otid(); id < 65536 + 524288; id += T) {
        int b, h, dir, e, d8, nc, c0; bool sample = id < 65536;
        int v = sample ? id : id - 65536;
        d8 = (v & 15) * 8; e = (v >> 4) & 255; dir = (v >> 12) & 1; h = (v >> 13) & 3; b = v >> 15;
        if (sample) { nc = 32; c0 = 64 + b * 32; } else { nc = 4; c0 = b * 4; }
        float run[8];
        if (sample) {
            const float* s0f = inp(5); const float* s0b = inp(6);
            const float* s0 = (dir == 0 ? s0f : s0b) + (size_t)(b * 4 + h) * 32768 + e;
#pragma unroll
            for (int q = 0; q < 8; ++q) run[q] = s0[(size_t)(d8 + q) * 256];
        } else {
#pragma unroll
            for (int q = 0; q < 8; ++q) run[q] = 0.f;
        }
        for (int i = 0; i < nc; ++i) {
            const int cs = dir == 0 ? i : nc - 1 - i;
            const int unit = (c0 + cs) * 4 + h;
            bf16_t* up = GU + ((size_t)(unit * 2 + dir) * 256 + e) * 128 + d8;
            const float* gp = GG + (size_t)(unit * 2 + dir) * 128 + d8;
            const u32x4 uv = *(const u32x4*)up;
            const f32x4 g0 = *(const f32x4*)gp, g1 = *(const f32x4*)(gp + 4);
            u32x4 sv; sv.x = pk2(run[0], run[1]); sv.y = pk2(run[2], run[3]); sv.z = pk2(run[4], run[5]); sv.w = pk2(run[6], run[7]);
            *(u32x4*)up = sv;
            run[0] = g0.x * run[0] + bflo(uv.x); run[1] = g0.y * run[1] + bfhi(uv.x);
            run[2] = g0.z * run[2] + bflo(uv.y); run[3] = g0.w * run[3] + bfhi(uv.y);
            run[4] = g1.x * run[4] + bflo(uv.z); run[5] = g1.y * run[5] + bfhi(uv.z);
            run[6] = g1.z * run[6] + bflo(uv.w); run[7] = g1.w * run[7] + bfhi(uv.w);
        }
        if (!sample) {
            float* o = p.out + (dir == 0 ? OUT_SF : OUT_SB) + (size_t)(b * 4 + h) * 32768 + e;
#pragma unroll
            for (int q = 0; q < 8; ++q) o[(size_t)(d8 + q) * 256] = run[q];
        }
    }
}

constexpr int AOP_STR = 328;
DEVI void phase_gla_c(const Params& p, unsigned char* smem) {
    const bf16_t* BIGb = (const bf16_t*)(p.ws + WS_BIG);
    const bf16_t* GQ = (const bf16_t*)(p.ws + WS_GQ);
    const bf16_t* GA = (const bf16_t*)(p.ws + WS_GA);
    const bf16_t* GU = (const bf16_t*)(p.ws + WS_GU);
    const bf16_t* GVT = (const bf16_t*)(p.ws + WS_GVT);
    bf16_t* Z = (bf16_t*)(p.ws + WS_Z);
    const float* ng = inp(23);
    bf16_t* aop = (bf16_t*)smem;
    float* red = (float*)(smem + 64 * AOP_STR * 2);
    const int tid = otid(), wave = tid >> 6, lane = tid & 63, fr = lane & 15, fq = lane >> 4;
    for (int unit = obid(); unit < 512; unit += gridDim.x) {
        const int c = unit >> 2, h = unit & 3, r0 = c * 64;
        for (int i = tid; i < 64 * 40; i += NTHREADS) {
            const int t = i / 40, ch = i - t * 40;
            u32x4 v;
            if (ch < 8) v = *(const u32x4*)(GA + ((size_t)unit * 64 + t) * 64 + ch * 8);
            else if (ch < 24) v = *(const u32x4*)(GQ + (size_t)(r0 + t) * 512 + h * 128 + (ch - 8) * 8);
            else v = *(const u32x4*)(GQ + (size_t)(MTOK + r0 + t) * 512 + h * 128 + (ch - 24) * 8);
            *(u32x4*)(aop + t * AOP_STR + ch * 8) = v;
        }
        __syncthreads();
        f32x4 acc[2][4];
#pragma unroll
        for (int a = 0; a < 2; ++a)
#pragma unroll
            for (int b = 0; b < 4; ++b) acc[a][b] = (f32x4){0, 0, 0, 0};
#pragma unroll
        for (int ks = 0; ks < 10; ++ks) {
            bf16x8 ef[2];
#pragma unroll
            for (int a = 0; a < 2; ++a) {
                const int e = (wave * 2 + a) * 16 + fr;
                const bf16_t* src;
                if (ks < 2) src = GVT + ((size_t)unit * 256 + e) * 64 + ks * 32 + fq * 8;
                else if (ks < 6) src = GU + ((size_t)(unit * 2 + 0) * 256 + e) * 128 + (ks - 2) * 32 + fq * 8;
                else src = GU + ((size_t)(unit * 2 + 1) * 256 + e) * 128 + (ks - 6) * 32 + fq * 8;
                ef[a] = *(const bf16x8*)src;
            }
#pragma unroll
            for (int b = 0; b < 4; ++b) {
                const bf16x8 tf = *(const bf16x8*)(aop + (b * 16 + fr) * AOP_STR + ks * 32 + fq * 8);
#pragma unroll
                for (int a = 0; a < 2; ++a) acc[a][b] = __builtin_amdgcn_mfma_f32_16x16x32_bf16(ef[a], tf, acc[a][b], 0, 0, 0);
            }
        }
#pragma unroll
        for (int b = 0; b < 4; ++b) {
            float ss = 0.f;
#pragma unroll
            for (int a = 0; a < 2; ++a) ss += (acc[a][b].x * acc[a][b].x + acc[a][b].y * acc[a][b].y) + (acc[a][b].z * acc[a][b].z + acc[a][b].w * acc[a][b].w);
            ss += __shfl_xor(ss, 16); ss += __shfl_xor(ss, 32);
            if (fq == 0) red[wave * 64 + b * 16 + fr] = ss;
        }
        __syncthreads();
#pragma unroll
        for (int b = 0; b < 4; ++b) {
            const int t = b * 16 + fr;
            float tot = 0.f;
#pragma unroll
            for (int w = 0; w < 8; ++w) tot += red[w * 64 + t];
            const float rstd = rsqrtf(tot * (1.f / 256.f) + 1e-6f);
#pragma unroll
            for (int a = 0; a < 2; ++a) {
                const int e0 = (wave * 2 + a) * 16 + fq * 4;
                const u32x2 ogv = *(const u32x2*)(BIGb + (size_t)(r0 + t) * GLD + 2048 + h * 256 + e0);
                const f32x4 g = *(const f32x4*)(ng + e0);
                const float o0 = acc[a][b].x * rstd * g.x * silu_f(bflo(ogv.x));
                const float o1 = acc[a][b].y * rstd * g.y * silu_f(bfhi(ogv.x));
                const float o2 = acc[a][b].z * rstd * g.z * silu_f(bflo(ogv.y));
                const float o3 = acc[a][b].w * rstd * g.w * silu_f(bfhi(ogv.y));
                u32x2 w; w.x = pk2(o0, o1); w.y = pk2(o2, o3);
                *(u32x2*)(Z + (size_t)(r0 + t) * D + h * 256 + e0) = w;
            }
        }
        __syncthreads();
    }
}

template <class Epi>
DEVI void run_gemm(unsigned char* smem, const bf16_t* A, const bf16_t* Bt, int N, int K, const Epi& E) {
    pg8::Gemm g{A, Bt, MTOK, N, K};
    pg8::StaticOrder S; S.init(MTOK, N, (int)gridDim.x, obid());
    pg8::gemm_phase<Epi, pg8::StaticOrder, true, true>((PG8_LAS unsigned char*)smem, g, S, E);
}

__global__ void __launch_bounds__(NTHREADS) mega_fwd(Params p) {
    extern __shared__ __attribute__((aligned(16))) unsigned char smem[];
    cg::grid_group grid = cg::this_grid();
#define GSYNC() do { grid.sync(); } while (0)

    phase_prep(p, smem);
    GSYNC();
    phase_modfinal(p);
    GSYNC();
    phase_rows<0>(p, nullptr, nullptr, (const float*)(p.ws + WS_MOD), 0, 1, false);
    GSYNC();
#ifndef DBG_LAYERS
#define DBG_LAYERS 4
#endif
#pragma unroll 1
    for (int l = 0; l < DBG_LAYERS; ++l) {
        const int kind = l % 3, j = l / 3;
        {
            const bf16_t* Win; int Nin;
            if (kind == 0) { Win = (const bf16_t*)(p.ws + WS_WCIN) + (size_t)j * 3072 * 1024; Nin = 3072; }
            else if (kind == 1) { Win = (const bf16_t*)(p.ws + WS_WQKV); Nin = 1536; }
            else { Win = (const bf16_t*)(p.ws + WS_WGIN); Nin = 3328; }
            pg8::EpiStore E{(bf16_t*)(p.ws + WS_BIG), Nin};
            run_gemm(smem, (const bf16_t*)(p.ws + WS_H), Win, Nin, 1024, E);
        }
        GSYNC();
        if (kind == 0) { phase_conv(p, j); }
        else if (kind == 1) { phase_attn_prep(p, smem); GSYNC(); phase_attn(p, smem); }
        else { phase_gla_a(p, smem); GSYNC(); phase_gla_scan(p); GSYNC(); phase_gla_c(p, smem); }
        GSYNC();
        {
            const bf16_t* Wout;
            if (kind == 0) Wout = (const bf16_t*)(p.ws + WS_WCOUT) + (size_t)j * 1024 * 1024;
            else if (kind == 1) Wout = (const bf16_t*)(p.ws + WS_WAO);
            else Wout = (const bf16_t*)(p.ws + WS_WGO);
            pg8::EpiResid E{(float*)(p.ws + WS_X), (const float*)(p.ws + WS_MOD) + (size_t)l * 3 * 6144 + 2 * 1024};
            run_gemm(smem, (const bf16_t*)(p.ws + WS_Z), Wout, 1024, 1024, E);
        }
        GSYNC();
        phase_rows<1>(p, inp(10) + (size_t)(l * 2 + 0) * D, inp(11) + (size_t)(l * 2 + 0) * D, (const float*)(p.ws + WS_MOD) + (size_t)l * 3 * 6144, 3, 4, false);
        GSYNC();
        {
            pg8::EpiSwiglu E{(bf16_t*)(p.ws + WS_BIG), DFF};
            run_gemm(smem, (const bf16_t*)(p.ws + WS_H), (const bf16_t*)(p.ws + WS_WFIN) + (size_t)l * 5632 * 1024, 5632, 1024, E);
        }
        GSYNC();
        {
            pg8::EpiResid E{(float*)(p.ws + WS_X), (const float*)(p.ws + WS_MOD) + (size_t)l * 3 * 6144 + 5 * 1024};
            run_gemm(smem, (const bf16_t*)(p.ws + WS_BIG), (const bf16_t*)(p.ws + WS_WFOUT) + (size_t)l * 1024 * 2816, 1024, 2816, E);
        }
        GSYNC();
        phase_rows<1>(p, inp(10) + (size_t)(l * 2 + 1) * D, inp(11) + (size_t)(l * 2 + 1) * D,
                      l < 3 ? (const float*)(p.ws + WS_MOD) + (size_t)(l + 1) * 3 * 6144 : nullptr, 0, 1, l == DBG_LAYERS - 1);
        GSYNC();
    }
}

extern "C" void kernel_launch(void* const* d_in, const int* in_sizes, int n_in, void* d_out, int out_size, void* d_ws, size_t ws_size, hipStream_t stream) {
    static int grid_blocks = 0;
    if (grid_blocks == 0) {
        if (n_in != 27 || ws_size < WS_END) { fprintf(stderr, "kernel_launch: unexpected n_in %d or ws_size %zu (< %zu)\n", n_in, ws_size, (size_t)WS_END); grid_blocks = -1; return; }
        int dev = 0, cus = 0, per_cu = 0;
        hipGetDevice(&dev);
        hipDeviceGetAttribute(&cus, hipDeviceAttributeMultiprocessorCount, dev);
        hipFuncSetAttribute((const void*)mega_fwd, hipFuncAttributeMaxDynamicSharedMemorySize, LDS_BYTES);
        hipOccupancyMaxActiveBlocksPerMultiprocessor(&per_cu, (const void*)mega_fwd, NTHREADS, LDS_BYTES);
        if (per_cu < 1) per_cu = 1;
        grid_blocks = cus * 1;
        (void)hipGetLastError();
    }
    if (grid_blocks < 0) return;
    Params p{};
    for (int i = 0; i < 27; ++i) p.in[i] = (const float*)d_in[i];
    p.out = (float*)d_out; p.ws = (unsigned char*)d_ws;
    void* args[] = {&p};
    hipError_t e = hipLaunchCooperativeKernel((const void*)mega_fwd, dim3(grid_blocks), dim3(NTHREADS), args, LDS_BYTES, stream);
    if (e != hipSuccess) fprintf(stderr, "cooperative launch failed: %s (grid %d)\n", hipGetErrorString(e), grid_blocks);
}
#ifdef PHASE_TEST
__global__ void __launch_bounds__(NTHREADS) t_gemm0(Params p, int N) { extern __shared__ __attribute__((aligned(16))) unsigned char smem[]; pg8::EpiStore E{(bf16_t*)(p.ws + WS_BIG), N}; run_gemm(smem, (const bf16_t*)(p.ws + WS_H), (const bf16_t*)(p.ws + WS_WCIN), N, 1024, E); }
__global__ void __launch_bounds__(NTHREADS) t_gemm1(Params p) { extern __shared__ __attribute__((aligned(16))) unsigned char smem[]; pg8::EpiSwiglu E{(bf16_t*)(p.ws + WS_BIG), DFF}; run_gemm(smem, (const bf16_t*)(p.ws + WS_H), (const bf16_t*)(p.ws + WS_WFIN), 5632, 1024, E); }
__global__ void __launch_bounds__(NTHREADS) t_gemm2(Params p, int K) { extern __shared__ __attribute__((aligned(16))) unsigned char smem[]; pg8::EpiResid E{(float*)(p.ws + WS_X), (const float*)(p.ws + WS_MOD)}; run_gemm(smem, (const bf16_t*)(p.ws + WS_Z), (const bf16_t*)(p.ws + WS_WCOUT), 1024, K, E); }
#endif
```

```cpp
#include <hip/hip_runtime.h>
#include <hip/hip_cooperative_groups.h>
#include <cstdio>
#include <cstdint>
namespace cg = cooperative_groups;

typedef unsigned short bf16_t;
typedef short bf16x8 __attribute__((ext_vector_type(8)));
typedef float f32x4 __attribute__((ext_vector_type(4)));
typedef unsigned u32x4 __attribute__((ext_vector_type(4)));
typedef unsigned u32x2 __attribute__((ext_vector_type(2)));
#define DEVI __device__ __forceinline__

constexpr int D = 1024, MTOK = 8192, MP = 4096, DFF = 2816;
constexpr float ALPHA = 1.6817928305074290f;
constexpr int NTHREADS = 512;
constexpr int LDS_PHASE = 139264;
constexpr int LDS_BYTES = LDS_PHASE + 16;

constexpr size_t WS_WCIN  = 0;
constexpr size_t WS_WCOUT = WS_WCIN  + 2ull * 3072 * 1024 * 2;
constexpr size_t WS_WQKV  = WS_WCOUT + 2ull * 1024 * 1024 * 2;
constexpr size_t WS_WAO   = WS_WQKV  + 1536ull * 1024 * 2;
constexpr size_t WS_WGIN  = WS_WAO   + 1024ull * 1024 * 2;
constexpr size_t WS_WGO   = WS_WGIN  + 3328ull * 1024 * 2;
constexpr size_t WS_WFIN  = WS_WGO   + 1024ull * 1024 * 2;
constexpr size_t WS_WFOUT = WS_WFIN  + 4ull * 5632 * 1024 * 2;
constexpr size_t WS_MODP  = WS_WFOUT + 4ull * 1024 * 2816 * 2;
constexpr size_t WS_MOD   = WS_MODP  + 16ull * 4 * 3 * 6144 * 4;
constexpr size_t WS_X     = WS_MOD   + 4ull * 3 * 6144 * 4;
constexpr size_t WS_H     = WS_X     + 8192ull * 1024 * 4;
constexpr size_t WS_BIG   = WS_H     + 8192ull * 1024 * 2;
constexpr size_t WS_Z     = WS_BIG   + 8192ull * 3328 * 2;
constexpr size_t WS_GQ    = WS_Z     + 8192ull * 1024 * 2;
constexpr size_t WS_GA    = WS_GQ    + 2ull * 8192 * 512 * 2;
constexpr size_t WS_GG    = WS_GA    + 512ull * 64 * 64 * 2;
constexpr size_t WS_GU    = WS_GG    + 1024ull * 128 * 4;
constexpr size_t WS_END   = WS_GU    + 1024ull * 256 * 128 * 2;
constexpr size_t WS_BAR   = WS_END;
constexpr size_t WS_TOTAL = WS_BAR + 16384;
constexpr size_t WS_GVT   = WS_H;
constexpr size_t WS_AQ    = WS_BIG + 8192ull * 1536 * 2;
constexpr size_t WS_AKP   = WS_AQ  + 8192ull * 1024 * 2;
constexpr size_t WS_AKS   = WS_AKP + 16ull * 256 * 256 * 2;
constexpr size_t WS_AVP   = WS_AKS + 2ull * 2304 * 256 * 2;
constexpr size_t WS_AVS   = WS_AVP + 16ull * 2 * 128 * 256 * 2;
static_assert(WS_AVS + 2ull * 2 * 128 * 2304 * 2 <= WS_Z, "attention buffers overflow BIG");

constexpr size_t OUT_Y = 0, OUT_CK = 8388608, OUT_CV = 9437184, OUT_SF = 10485760, OUT_SB = 12582912;

struct Params {
    const float* in[27];
    float* out;
    unsigned char* ws;
};
__device__ __forceinline__ int otid() { int t = threadIdx.x; asm volatile("" : "+v"(t)); return t; }
__device__ __forceinline__ int obid() { int b = blockIdx.x; asm volatile("" : "+s"(b)); return b; }
__device__ __forceinline__ const float* inp(int i) {
    const float* const* ka = (const float* const*)__builtin_amdgcn_kernarg_segment_ptr();
    asm volatile("" : "+s"(i));
    return ka[i];
}

typedef float f32x2_t __attribute__((ext_vector_type(2)));
typedef __bf16 bf16x2_t __attribute__((ext_vector_type(2)));
DEVI unsigned pk2(float lo, float hi) { f32x2_t v = {lo, hi}; bf16x2_t b = __builtin_convertvector(v, bf16x2_t); return __builtin_bit_cast(unsigned, b); }
DEVI float bflo(unsigned u) { return __uint_as_float(u << 16); }
DEVI float bfhi(unsigned u) { return __uint_as_float(u & 0xffff0000u); }
DEVI float bf2f(bf16_t u) { return __uint_as_float(((unsigned)u) << 16); }
DEVI float silu_f(float x) { return x * __builtin_amdgcn_rcpf(1.f + __expf(-x)); }
DEVI float wave_sum(float v) {
#pragma unroll
    for (int o = 1; o < 64; o <<= 1) v += __shfl_xor(v, o);
    return v;
}
DEVI int row_cond(int row) { return row < MP ? 0 : 1 + ((row - MP) >> 11); }

struct TJob { int in_idx, src_off, K, N, map, row_off, dst_ld; unsigned dst_off; };
__device__ const TJob g_jobs[18] = {
    {12, 0,               1024, 3072, 0, 0, 1024, (unsigned)WS_WCIN},
    {12, 1024 * 3072,     1024, 3072, 0, 0, 1024, (unsigned)(WS_WCIN + 3072ull * 1024 * 2)},
    {14, 0,               1024, 1024, 0, 0, 1024, (unsigned)WS_WCOUT},
    {14, 1024 * 1024,     1024, 1024, 0, 0, 1024, (unsigned)(WS_WCOUT + 1024ull * 1024 * 2)},
    {15, 0,               1024, 1536, 0, 0, 1024, (unsigned)WS_WQKV},
    {18, 0,               1024, 1024, 0, 0, 1024, (unsigned)WS_WAO},
    {19, 0,               1024, 3072, 0, 0, 1024, (unsigned)WS_WGIN},
    {20, 0,               1024, 16,   0, 3072, 1024, (unsigned)WS_WGIN},
    {20, 1024 * 16,       1024, 16,   0, 3088, 1024, (unsigned)WS_WGIN},
    {24, 0,               1024, 1024, 0, 0, 1024, (unsigned)WS_WGO},
    {25, 0,               1024, 5632, 1, 0, 1024, (unsigned)WS_WFIN},
    {25, 1024 * 5632,     1024, 5632, 1, 0, 1024, (unsigned)(WS_WFIN + 1ull * 5632 * 1024 * 2)},
    {25, 2 * 1024 * 5632, 1024, 5632, 1, 0, 1024, (unsigned)(WS_WFIN + 2ull * 5632 * 1024 * 2)},
    {25, 3 * 1024 * 5632, 1024, 5632, 1, 0, 1024, (unsigned)(WS_WFIN + 3ull * 5632 * 1024 * 2)},
    {26, 0,               2816, 1024, 0, 0, 2816, (unsigned)WS_WFOUT},
    {26, 2816 * 1024,     2816, 1024, 0, 0, 2816, (unsigned)(WS_WFOUT + 1ull * 1024 * 2816 * 2)},
    {26, 2 * 2816 * 1024, 2816, 1024, 0, 0, 2816, (unsigned)(WS_WFOUT + 2ull * 1024 * 2816 * 2)},
    {26, 3 * 2816 * 1024, 2816, 1024, 0, 0, 2816, (unsigned)(WS_WFOUT + 3ull * 1024 * 2816 * 2)},
};
constexpr int N_MODJOBS = 192;

DEVI void transpose_item(const float* W, int K, int N, int map, bf16_t* dst, int dst_ld, int row_off, int item, float* tl) {
    const int nb = (N + 63) >> 6;
    const int kb = item / nb, nbi = item - kb * nb, k0 = kb * 64, n0 = nbi * 64;
    const int tid = otid();
    {
        const int c = tid & 63, r = tid >> 6, n = n0 + c;
#pragma unroll
        for (int i = 0; i < 8; ++i) { const int kk = r + 8 * i; tl[kk * 65 + c] = (n < N) ? W[(size_t)(k0 + kk) * N + n] : 0.f; }
    }
    __syncthreads();
    {
        const int kp = tid & 31, nr = tid >> 5;
#pragma unroll
        for (int i = 0; i < 4; ++i) {
            const int nl = nr + 16 * i, n = n0 + nl;
            if (n < N) {
                int np = n;
                if (map == 1) np = (n < DFF) ? (256 * (n >> 7) + (n & 127)) : (256 * ((n - DFF) >> 7) + 128 + ((n - DFF) & 127));
                const float a = tl[(2 * kp) * 65 + nl], b = tl[(2 * kp + 1) * 65 + nl];
                *(unsigned*)(dst + (size_t)(row_off + np) * dst_ld + k0 + 2 * kp) = pk2(a, b);
            }
        }
    }
    __syncthreads();
}

DEVI void mod_job(const Params& p, int job, float* sl) {
    const int third = job % 3, lk = job / 3, kc = lk & 15, l = lk >> 4;
    const int tid = otid();
    if (tid < 192) {
        const int c = tid >> 6, kk = tid & 63, k = kc * 64 + kk;
        const float x = (c == 0) ? inp(7)[k] : inp(2)[(c - 1) * 1024 + k];
        sl[c * 64 + kk] = silu_f(x);
    }
    __syncthreads();
    const int n0 = third * 2048 + tid * 4;
    const float* W = inp(8) + (size_t)l * 1024 * 6144 + (size_t)(kc * 64) * 6144 + n0;
    f32x4 a0 = {0, 0, 0, 0}, a1 = a0, a2 = a0;
#pragma unroll 8
    for (int kk = 0; kk < 64; ++kk) {
        const f32x4 w = *(const f32x4*)(W + (size_t)kk * 6144);
        a0 += w * sl[kk]; a1 += w * sl[64 + kk]; a2 += w * sl[128 + kk];
    }
    float* P = (float*)(p.ws + WS_MODP) + (size_t)((kc * 4 + l) * 3) * 6144 + n0;
    *(f32x4*)(P) = a0; *(f32x4*)(P + 6144) = a1; *(f32x4*)(P + 2 * 6144) = a2;
    __syncthreads();
}

DEVI void phase_prep(const Params& p, unsigned char* smem) {
    float* tl = (float*)smem;
    int total = N_MODJOBS;
    int jstart[19];
#pragma unroll
    for (int j = 0; j < 18; ++j) { jstart[j] = total; total += (g_jobs[j].K >> 6) * ((g_jobs[j].N + 63) >> 6); }
    jstart[18] = total;
    for (int it = obid(); it < total; it += gridDim.x) {
        if (it < N_MODJOBS) { mod_job(p, it, tl); continue; }
        int j = 0;
#pragma unroll
        for (int q = 1; q < 18; ++q) if (it >= jstart[q]) j = q;
        const TJob jb = g_jobs[j];
        transpose_item(inp(__builtin_amdgcn_readfirstlane(jb.in_idx)) + jb.src_off, jb.K, jb.N, jb.map, (bf16_t*)(p.ws + jb.dst_off), jb.dst_ld, jb.row_off, it - jstart[j], tl);
    }
    {
        u32x4* z = (u32x4*)(p.ws + WS_WGIN + 3104ull * 1024 * 2);
        const int n16 = 224 * 1024 * 2 / 16;
        for (int i = obid() * NTHREADS + otid(); i < n16; i += gridDim.x * NTHREADS) z[i] = (u32x4){0, 0, 0, 0};
    }
}

DEVI void phase_modfinal(const Params& p) {
    const float* P = (const float*)(p.ws + WS_MODP);
    float* Mo = (float*)(p.ws + WS_MOD);
    for (int idx = obid() * NTHREADS + otid(); idx < 4 * 3 * 6144; idx += gridDim.x * NTHREADS) {
        const int l = idx / 18432, rem = idx - l * 18432, c = rem / 6144, j = rem - c * 6144;
        float s = inp(9)[l * 6144 + j];
#pragma unroll
        for (int kc = 0; kc < 16; ++kc) s += P[(size_t)((kc * 4 + l) * 3 + c) * 6144 + j];
        Mo[idx] = s;
    }
}

template <int MODE>
DEVI void phase_rows(const Params& p, const float* lng, const float* lnb, const float* modn, int ch_sh, int ch_sc, bool write_out) {
    float* X = (float*)(p.ws + WS_X);
    bf16_t* H = (bf16_t*)(p.ws + WS_H);
    const int lane = otid() & 63;
    const int gw = obid() * 8 + (otid() >> 6), NW = gridDim.x * 8;
    for (int row = gw; row < MTOK; row += NW) {
        const float* src = (MODE == 0) ? (row < MP ? inp(0) + (size_t)row * D : inp(1) + (size_t)(row - MP) * D) : X + (size_t)row * D;
        f32x4 v[4];
#pragma unroll
        for (int j = 0; j < 4; ++j) v[j] = ((const f32x4*)src)[lane + 64 * j];
        if (MODE == 1) {
            float s = 0.f;
#pragma unroll
            for (int j = 0; j < 4; ++j) s += (v[j].x + v[j].y) + (v[j].z + v[j].w);
            const float mean = wave_sum(s) * (1.f / D);
            float s2 = 0.f;
#pragma unroll
            for (int j = 0; j < 4; ++j) { v[j] = v[j] - mean; s2 += (v[j].x * v[j].x + v[j].y * v[j].y) + (v[j].z * v[j].z + v[j].w * v[j].w); }
            const float rstd = rsqrtf(wave_sum(s2) * (1.f / D) + 1e-5f);
#pragma unroll
            for (int j = 0; j < 4; ++j) {
                const f32x4 g = ((const f32x4*)lng)[lane + 64 * j], b = ((const f32x4*)lnb)[lane + 64 * j];
                v[j] = v[j] * rstd * g + b;
            }
        }
#pragma unroll
        for (int j = 0; j < 4; ++j) ((f32x4*)(X + (size_t)row * D))[lane + 64 * j] = v[j];
        if (write_out) {
#pragma unroll
            for (int j = 0; j < 4; ++j) ((f32x4*)(p.out + OUT_Y + (size_t)row * D))[lane + 64 * j] = v[j];
        }
        if (modn) {
            const int cond = row_cond(row);
            const float* sc = modn + cond * 6144 + ch_sc * 1024;
            const float* sh = modn + cond * 6144 + ch_sh * 1024;
#pragma unroll
            for (int j = 0; j < 4; ++j) {
                const f32x4 a = ((const f32x4*)sc)[lane + 64 * j], b = ((const f32x4*)sh)[lane + 64 * j];
                const f32x4 h = v[j] * (a + 1.f) + b;
                u32x2 o; o.x = pk2(h.x, h.y); o.y = pk2(h.z, h.w);
                ((u32x2*)(H + (size_t)row * D))[lane + 64 * j] = o;
            }
        }
    }
}

namespace pg8 {
#define PG8_LAS __attribute__((address_space(3)))
constexpr int BM = 256, BK = 64, HALF = 128, HTB = HALF * BK * 2, STAGE_BYTES = 8 * HTB, NXCD = 8, WGM = 8;
DEVI int lds_byte(int r, int c) { const int st = (r >> 4) * 2 + (c >> 5), rr = r & 15, cc = c & 31, ob = rr * 64 + cc * 2; return st * 1024 + (ob ^ (((ob >> 9) & 1) << 5)); }
DEVI void stage_rc(int b, int& R, int& C) { const int st = b / 1024, sb = b % 1024, swz = sb ^ (((sb >> 9) & 1) << 5); R = (st >> 1) * 16 + swz / 64; C = (st & 1) * 32 + (swz % 64) / 2; }
DEVI int perm32(int rho) { const int n = rho >> 4, i = rho & 15; return 8 * (i >> 2) + 4 * n + (i & 3); }
struct Unit { int pm, pn; };
struct Gemm { const bf16_t* A; const bf16_t* Bt; int M, N, K; };
struct StaticOrder {
    int nM, nN, nwg, G, c;
    DEVI void init(int M, int N, int G_, int c_) { nM = M / BM; nN = N / BM; nwg = nM * nN; G = G_; c = c_; }
    DEVI bool next(int i, Unit& u) const {
        const long L = (long)i * G + c; if (L >= nwg) return false;
        int wgid = (int)L; { const int q = nwg / NXCD, r = nwg % NXCD, xcd = wgid % NXCD, off = wgid / NXCD; wgid = (xcd < r ? xcd * (q + 1) : r * (q + 1) + (xcd - r) * q) + off; }
        const int nig = WGM * nN, gid = wgid / nig, fm = gid * WGM, gsz = (nM - fm) < WGM ? (nM - fm) : WGM;
        u.pm = fm + ((wgid % nig) % gsz); u.pn = (wgid % nig) / gsz; return true;
    }
    DEVI void a_ready(const Unit&) const {}
    DEVI void done(const Unit&) const {}
};
struct EpiStore {
    static constexpr bool PERM = true, AFTER_DRAIN = false;
    bf16_t* O; int ldo;
    DEVI void operator()(const f32x4 (&acc)[2][2][4][2], const Unit& u, int wr, int wc, int fr, int fq) const {
        const int row0 = u.pm * BM + wr * 64 + fr, col0 = u.pn * BM + wc * 32 + 8 * fq;
#pragma unroll
        for (int ai = 0; ai < 2; ++ai)
#pragma unroll
            for (int m = 0; m < 4; ++m) { bf16_t* rowp = O + (size_t)(row0 + ai * HALF + m * 16) * ldo + col0;
#pragma unroll
                for (int bj = 0; bj < 2; ++bj) { const f32x4 v0 = acc[ai][bj][m][0], v1 = acc[ai][bj][m][1];
                    u32x4 w; w.x = pk2(v0[0], v0[1]); w.y = pk2(v0[2], v0[3]); w.z = pk2(v1[0], v1[1]); w.w = pk2(v1[2], v1[3]);
                    *(u32x4*)(rowp + bj * HALF) = w; } }
    }
};
struct EpiSwiglu {
    static constexpr bool PERM = true, AFTER_DRAIN = false;
    bf16_t* O; int ldo;
    DEVI void operator()(const f32x4 (&acc)[2][2][4][2], const Unit& u, int wr, int wc, int fr, int fq) const {
        const int row0 = u.pm * BM + wr * 64 + fr, col0 = u.pn * HALF + wc * 32 + 8 * fq;
#pragma unroll
        for (int ai = 0; ai < 2; ++ai)
#pragma unroll
            for (int m = 0; m < 4; ++m) { bf16_t* rowp = O + (size_t)(row0 + ai * HALF + m * 16) * ldo + col0;
                const f32x4 g0 = acc[ai][0][m][0], g1 = acc[ai][0][m][1], u0 = acc[ai][1][m][0], u1 = acc[ai][1][m][1];
                u32x4 w; w.x = pk2(silu_f(g0[0]) * u0[0], silu_f(g0[1]) * u0[1]); w.y = pk2(silu_f(g0[2]) * u0[2], silu_f(g0[3]) * u0[3]);
                w.z = pk2(silu_f(g1[0]) * u1[0], silu_f(g1[1]) * u1[1]); w.w = pk2(silu_f(g1[2]) * u1[2], silu_f(g1[3]) * u1[3]);
                *(u32x4*)rowp = w; }
    }
};
struct EpiResid {
    static constexpr bool PERM = true, AFTER_DRAIN = false;
    float* X; const float* ga;
    DEVI void operator()(const f32x4 (&acc)[2][2][4][2], const Unit& u, int wr, int wc, int fr, int fq) const {
        const int row0 = u.pm * BM + wr * 64 + fr, col0 = u.pn * BM + wc * 32 + 8 * fq;
        const int cond = u.pm < 16 ? 0 : 1 + ((u.pm - 16) >> 3);
        const float* g = ga + cond * 6144 + col0;
#pragma unroll
        for (int bj = 0; bj < 2; ++bj) {
            const f32x4 g0 = *(const f32x4*)(g + bj * HALF), g1 = *(const f32x4*)(g + bj * HALF + 4);
#pragma unroll
            for (int ai = 0; ai < 2; ++ai)
#pragma unroll
                for (int m = 0; m < 4; ++m) { float* xp = X + (size_t)(row0 + ai * HALF + m * 16) * D + col0 + bj * HALF;
                    const f32x4 x0 = *(const f32x4*)xp, x1 = *(const f32x4*)(xp + 4);
                    *(f32x4*)xp = x0 * ALPHA + g0 * acc[ai][bj][m][0]; *(f32x4*)(xp + 4) = x1 * ALPHA + g1 * acc[ai][bj][m][1]; }
        }
    }
};
template <class Epi, class Sched, bool ALIGN_EPI = false, bool SP2 = false>
__device__ __forceinline__ void gemm_phase(PG8_LAS unsigned char* lds, const Gemm g, const Sched& S, const Epi& E) {
    const int tid = otid(), wid = __builtin_amdgcn_readfirstlane(tid >> 6), lane = tid & 63, wr = wid >> 2, wc = wid & 3, fr = lane & 15, fq = lane >> 4;
    const int K = g.K, nt = K / BK;
    unsigned voffA[2], voffB[2];
#pragma unroll
    for (int i = 0; i < 2; ++i) { int R, C; stage_rc(tid * 16 + i * 8192, R, C); const int Rb = Epi::PERM ? ((R & ~31) + perm32(R & 31)) : R;
        voffA[i] = (unsigned)(R * K + C) * 2u; voffB[i] = (unsigned)(Rb * K + C) * 2u; }
    const size_t kstep = (size_t)(BK * 2);
    const size_t hstep = (size_t)HALF * K * 2;
    const size_t tstep = 2 * hstep;
    const unsigned ldsw = (unsigned)wid * 1024u;
    const int aoff = lds_byte(wr * 64 + fr, fq * 8), boff = lds_byte(wc * 32 + fr, fq * 8);
#define PG8_SA(b, h) (((b) * 2 + (h)) * HTB)
#define PG8_SB(b, h) ((4 + (b) * 2 + (h)) * HTB)
#define PG8_STAGE(bufoff, gbase, voff) do { _Pragma("unroll") for (int _i = 0; _i < 2; ++_i) \
        __builtin_amdgcn_global_load_lds((const unsigned*)((const char*)(gbase) + (voff)[_i]), (PG8_LAS unsigned*)(lds + (bufoff) + ldsw + _i * 8192), 16, 0, 0); } while (0)
#define PG8_LDA(dst, b, h) do { _Pragma("unroll") for (int m = 0; m < 4; ++m) _Pragma("unroll") for (int k = 0; k < 2; ++k) dst[m][k] = *(const PG8_LAS bf16x8*)(lds + PG8_SA(b, h) + aoff + m * 2048 + k * 1024); } while (0)
#define PG8_LDB(dst, b, h) do { _Pragma("unroll") for (int n = 0; n < 2; ++n) _Pragma("unroll") for (int k = 0; k < 2; ++k) dst[n][k] = *(const PG8_LAS bf16x8*)(lds + PG8_SB(b, h) + boff + n * 2048 + k * 1024); } while (0)
#define PG8_MMA(ai, bj, At, Bt) do { __builtin_amdgcn_s_setprio(1); _Pragma("unroll") for (int m = 0; m < 4; ++m) _Pragma("unroll") for (int n = 0; n < 2; ++n) _Pragma("unroll") for (int k = 0; k < 2; ++k) \
        acc[ai][bj][m][n] = __builtin_amdgcn_mfma_f32_16x16x32_bf16(Bt[n][k], At[m][k], acc[ai][bj][m][n], 0, 0, 0); __builtin_amdgcn_s_setprio(0); } while (0)
#define PG8_WAIT_V(n) asm volatile("s_waitcnt vmcnt(" #n ")" ::: "memory")
#define PG8_WAIT_L(n) asm volatile("s_waitcnt lgkmcnt(" #n ")" ::: "memory")
#define PG8_BAR __builtin_amdgcn_s_barrier()
#define PG8_SCHED __builtin_amdgcn_sched_barrier(0)
    Unit cur, nxt; int ui = 0;
    if (!S.next(0, cur)) return;
    f32x4 acc[2][2][4][2];
#pragma unroll
    for (int a = 0; a < 2; ++a)
#pragma unroll
        for (int b = 0; b < 2; ++b)
#pragma unroll
            for (int m = 0; m < 4; ++m)
#pragma unroll
                for (int n = 0; n < 2; ++n) acc[a][b][m][n] = (f32x4){0.f, 0.f, 0.f, 0.f};
    bf16x8 At[4][2], B0[2][2], B1[2][2];
    const char* cA = (const char*)g.A + (size_t)cur.pm * tstep; const char* cB = (const char*)g.Bt + (size_t)cur.pn * tstep;
    S.a_ready(cur);
    if constexpr (SP2) {
        PG8_STAGE(PG8_SB(0, 0), cB, voffB); PG8_STAGE(PG8_SB(0, 1), cB + hstep, voffB); PG8_STAGE(PG8_SA(0, 0), cA, voffA); PG8_STAGE(PG8_SA(0, 1), cA + hstep, voffA);
        if (wr == 1) PG8_BAR;
        PG8_WAIT_V(2); PG8_BAR;
        PG8_STAGE(PG8_SB(1, 0), cB + kstep, voffB); PG8_STAGE(PG8_SA(1, 0), cA + kstep, voffA); PG8_STAGE(PG8_SB(1, 1), cB + hstep + kstep, voffB);
        PG8_WAIT_V(6); PG8_BAR;
    } else {
        PG8_STAGE(PG8_SB(0, 0), cB, voffB); PG8_STAGE(PG8_SA(0, 0), cA, voffA); PG8_STAGE(PG8_SB(0, 1), cB + hstep, voffB); PG8_STAGE(PG8_SA(0, 1), cA + hstep, voffA);
        if (wr == 1) PG8_BAR;
        PG8_WAIT_V(4); PG8_BAR;
        PG8_STAGE(PG8_SB(1, 0), cB + kstep, voffB); PG8_STAGE(PG8_SA(1, 0), cA + kstep, voffA); PG8_STAGE(PG8_SB(1, 1), cB + hstep + kstep, voffB);
        PG8_WAIT_V(6); PG8_BAR;
    }
    for (;;) {
        const bool has_next = S.next(ui + 1, nxt);
        const char* nA = has_next ? (const char*)g.A + (size_t)nxt.pm * tstep : cA; const char* nB = has_next ? (const char*)g.Bt + (size_t)nxt.pn * tstep : cB;
        for (int t = 0; t < nt; t += 2) {
            const bool last = (t == nt - 2);
            const char* a1 = cA + (size_t)(t + 1) * kstep;
            const char* a2 = last ? nA : cA + (size_t)(t + 2) * kstep; const char* b2 = last ? nB : cB + (size_t)(t + 2) * kstep;
            const char* a3 = a2 + kstep; const char* b3 = b2 + kstep;
            if (last && has_next) S.a_ready(nxt);
            if constexpr (SP2) {
            PG8_LDB(B0, 0, 0); PG8_LDB(B1, 0, 1); PG8_SCHED; PG8_LDA(At, 0, 0); PG8_STAGE(PG8_SA(1, 1), a1 + hstep, voffA);
            PG8_WAIT_V(8); PG8_WAIT_L(0); PG8_BAR; PG8_MMA(0, 0, At, B0); PG8_MMA(0, 1, At, B1); PG8_BAR; PG8_SCHED;
            PG8_LDA(At, 0, 1); PG8_STAGE(PG8_SB(0, 0), b2, voffB); PG8_STAGE(PG8_SB(0, 1), b2 + hstep, voffB); PG8_STAGE(PG8_SA(0, 0), a2, voffA);
            PG8_WAIT_V(8); PG8_WAIT_L(0); PG8_BAR; PG8_MMA(1, 0, At, B0); PG8_MMA(1, 1, At, B1); PG8_BAR; PG8_SCHED;
            PG8_LDB(B0, 1, 0); PG8_LDB(B1, 1, 1); PG8_SCHED; PG8_LDA(At, 1, 0); PG8_STAGE(PG8_SA(0, 1), a2 + hstep, voffA);
            PG8_WAIT_V(8); PG8_WAIT_L(0); PG8_BAR; PG8_MMA(0, 0, At, B0); PG8_MMA(0, 1, At, B1); PG8_BAR; PG8_SCHED;
            PG8_LDA(At, 1, 1); PG8_STAGE(PG8_SB(1, 0), b3, voffB); PG8_STAGE(PG8_SB(1, 1), b3 + hstep, voffB); PG8_STAGE(PG8_SA(1, 0), a3, voffA);
            PG8_WAIT_V(8); PG8_WAIT_L(0); PG8_BAR; PG8_MMA(1, 0, At, B0); PG8_MMA(1, 1, At, B1); PG8_BAR; PG8_SCHED;
            } else {
            PG8_LDB(B0, 0, 0); PG8_SCHED; PG8_LDA(At, 0, 0); PG8_STAGE(PG8_SA(1, 1), a1 + hstep, voffA);
            PG8_WAIT_L(8); PG8_BAR; PG8_WAIT_L(0); PG8_MMA(0, 0, At, B0); PG8_BAR; PG8_SCHED;
            PG8_LDB(B1, 0, 1); PG8_STAGE(PG8_SB(0, 0), b2, voffB);
            PG8_BAR; PG8_WAIT_L(0); PG8_MMA(0, 1, At, B1); PG8_BAR;
            PG8_LDA(At, 0, 1); PG8_STAGE(PG8_SA(0, 0), a2, voffA);
            PG8_BAR; PG8_WAIT_L(0); PG8_MMA(1, 0, At, B0); PG8_BAR; PG8_SCHED;
            PG8_STAGE(PG8_SB(0, 1), b2 + hstep, voffB);
            PG8_WAIT_V(6); PG8_BAR; PG8_MMA(1, 1, At, B1); PG8_BAR;
            PG8_LDB(B0, 1, 0); PG8_SCHED; PG8_LDA(At, 1, 0); PG8_STAGE(PG8_SA(0, 1), a2 + hstep, voffA);
            PG8_WAIT_L(8); PG8_BAR; PG8_WAIT_L(0); PG8_MMA(0, 0, At, B0); PG8_BAR; PG8_SCHED;
            PG8_LDB(B1, 1, 1); PG8_STAGE(PG8_SB(1, 0), b3, voffB);
            PG8_BAR; PG8_WAIT_L(0); PG8_MMA(0, 1, At, B1); PG8_BAR;
            PG8_LDA(At, 1, 1); PG8_STAGE(PG8_SA(1, 0), a3, voffA);
            PG8_BAR; PG8_WAIT_L(0); PG8_MMA(1, 0, At, B0); PG8_BAR; PG8_SCHED;
            PG8_STAGE(PG8_SB(1, 1), b3 + hstep, voffB);
            PG8_WAIT_V(6); PG8_BAR; PG8_MMA(1, 1, At, B1); PG8_BAR;
            }
        }
        if constexpr (ALIGN_EPI) { if (wr == 0) PG8_BAR; }
        if constexpr (!Epi::AFTER_DRAIN) { E(acc, cur, wr, wc, fr, fq); S.done(cur); }
        if (!has_next) break;
#pragma unroll
        for (int a = 0; a < 2; ++a)
#pragma unroll
            for (int b = 0; b < 2; ++b)
#pragma unroll
                for (int m = 0; m < 4; ++m)
#pragma unroll
                    for (int n = 0; n < 2; ++n) acc[a][b][m][n] = (f32x4){0.f, 0.f, 0.f, 0.f};
        cur = nxt; cA = nA; cB = nB; ++ui;
        if constexpr (ALIGN_EPI) { if (wr == 1) PG8_BAR; }
    }
    PG8_WAIT_V(0);
    if constexpr (!ALIGN_EPI) { if (wr == 0) PG8_BAR; }
    PG8_BAR;
    if constexpr (Epi::AFTER_DRAIN) { E.fused(acc, cur, wr, wc, fr, fq, lds, wid, lane); S.done(cur); }
#undef PG8_SA
#undef PG8_SB
#undef PG8_STAGE
#undef PG8_LDA
#undef PG8_LDB
#undef PG8_MMA
#undef PG8_WAIT_V
#undef PG8_WAIT_L
#undef PG8_BAR
#undef PG8_SCHED
}
}

DEVI void phase_conv(const Params& p, int j) {
    const bf16_t* U = (const bf16_t*)(p.ws + WS_BIG);
    bf16_t* Z = (bf16_t*)(p.ws + WS_Z);
    const float* cw = inp(13) + (size_t)j * 3 * D;
    for (int it = obid() * NTHREADS + otid(); it < MTOK * 128; it += gridDim.x * NTHREADS) {
        const int row = it >> 7, c8 = (it & 127) * 8;
        int s, Ls; if (row < MP) { s = row & 255; Ls = 256; } else { s = (row - MP) & 2047; Ls = 2048; }
        const bf16_t* ur = U + (size_t)row * 3072;
        const u32x4 bg = *(const u32x4*)(ur + c8);
        const u32x4 c0 = *(const u32x4*)(ur + 1024 + c8), u0 = *(const u32x4*)(ur + 2048 + c8);
        u32x4 cp = {0, 0, 0, 0}, up = cp, cn = cp, un = cp;
        if (s > 0) { cp = *(const u32x4*)(ur - 3072 + 1024 + c8); up = *(const u32x4*)(ur - 3072 + 2048 + c8); }
        if (s < Ls - 1) { cn = *(const u32x4*)(ur + 3072 + 1024 + c8); un = *(const u32x4*)(ur + 3072 + 2048 + c8); }
        float w0[8], w1[8], w2[8];
#pragma unroll
        for (int i = 0; i < 2; ++i) {
            const f32x4 a = *(const f32x4*)(cw + c8 + 4 * i), b = *(const f32x4*)(cw + D + c8 + 4 * i), c = *(const f32x4*)(cw + 2 * D + c8 + 4 * i);
#pragma unroll
            for (int q = 0; q < 4; ++q) { w0[4 * i + q] = a[q]; w1[4 * i + q] = b[q]; w2[4 * i + q] = c[q]; }
        }
        u32x4 o;
#pragma unroll
        for (int q = 0; q < 4; ++q) {
            const float vlo = bflo(bg[q]) * (w0[2 * q] * bflo(cp[q]) * bflo(up[q]) + w1[2 * q] * bflo(c0[q]) * bflo(u0[q]) + w2[2 * q] * bflo(cn[q]) * bflo(un[q]));
            const float vhi = bfhi(bg[q]) * (w0[2 * q + 1] * bfhi(cp[q]) * bfhi(up[q]) + w1[2 * q + 1] * bfhi(c0[q]) * bfhi(u0[q]) + w2[2 * q + 1] * bfhi(cn[q]) * bfhi(un[q]));
            o[q] = pk2(vlo, vhi);
        }
        *(u32x4*)(Z + (size_t)row * D + c8) = o;
    }
}

DEVI void phase_attn_prep(const Params& p, unsigned char* smem) {
    const bf16_t* QKV = (const bf16_t*)(p.ws + WS_BIG);
    bf16_t* Qb = (bf16_t*)(p.ws + WS_AQ);
    bf16_t* KP = (bf16_t*)(p.ws + WS_AKP);
    bf16_t* KS = (bf16_t*)(p.ws + WS_AKS);
    bf16_t* VP = (bf16_t*)(p.ws + WS_AVP);
    bf16_t* VS = (bf16_t*)(p.ws + WS_AVS);
    const float* qg = inp(16); const float* kg = inp(17);
    const int lane = otid() & 63;
    const int gw = obid() * 8 + (otid() >> 6), NW = gridDim.x * 8;
    const int axis = lane >> 5, f = lane & 31;
    const int i1 = axis * 64 + f, i2 = i1 + 32;
    const float freq = exp2f(-(float)f * (13.287712379549449f / 32.f));
    for (int it = gw; it < MTOK * 10; it += NW) {
        const int row = it / 10, slot = it - row * 10;
        const bf16_t* src = QKV + (size_t)row * 1536 + slot * 128;
        float x1 = bf2f(src[i1]), x2 = bf2f(src[i2]);
        const float ss = wave_sum(x1 * x1 + x2 * x2);
        const float rstd = rsqrtf(ss * (1.f / 128.f) + 1e-6f);
        const float* g = slot < 8 ? qg : kg;
        x1 = x1 * rstd * g[i1]; x2 = x2 * rstd * g[i2];
        if (row >= MP) {
            const int s = (row - MP) & 2047;
            const float pos = axis == 0 ? (float)(s >> 6) : (float)(s & 63);
            float sn, cs; sincosf(pos * freq, &sn, &cs);
            const float y1 = x1 * cs - x2 * sn, y2 = x2 * cs + x1 * sn;
            x1 = y1; x2 = y2;
        }
        if (slot < 8) {
            const float sc = 0.08838834764831845f * 1.4426950408889634f;
            bf16_t* d = Qb + (size_t)row * D + slot * 128;
            d[i1] = (bf16_t)(pk2(x1 * sc, 0.f) & 0xffff); d[i2] = (bf16_t)(pk2(x2 * sc, 0.f) & 0xffff);
        } else {
            const int kvh = slot - 8;
            bf16_t* d;
            if (row < MP) {
                d = KP + (size_t)row * 256 + kvh * 128;
                float* o = p.out + OUT_CK + (size_t)row * 256 + kvh * 128;
                o[i1] = x1; o[i2] = x2;
            } else {
                const int b = (row - MP) >> 11, s = (row - MP) & 2047;
                d = KS + ((size_t)b * 2304 + 256 + s) * 256 + kvh * 128;
            }
            d[i1] = (bf16_t)(pk2(x1, 0.f) & 0xffff); d[i2] = (bf16_t)(pk2(x2, 0.f) & 0xffff);
        }
    }
    for (int it = obid() * NTHREADS + otid(); it < 2 * 256 * 256 / 4; it += gridDim.x * NTHREADS) {
        const int e = it * 4, b = e >> 16, r = e & 65535;
        const f32x4 v = *(const f32x4*)(inp(3) + e);
        u32x2 o; o.x = pk2(v.x, v.y); o.y = pk2(v.z, v.w);
        *(u32x2*)(KS + (size_t)b * 2304 * 256 + r) = o;
    }
    bf16_t* vl = (bf16_t*)smem;
    for (int job = obid(); job < 64 + 72; job += gridDim.x) {
        int nkeys, kb; bf16_t* dst; const bf16_t* srcb = nullptr; const float* srcf = nullptr; float* outv = nullptr;
        if (job < 64) { const int b = job >> 2; kb = job & 3; nkeys = 256; dst = VP + (size_t)b * 2 * 128 * 256;
            srcb = QKV + (size_t)(b * 256 + kb * 64) * 1536 + 1280; outv = p.out + OUT_CV + (size_t)(b * 256 + kb * 64) * 256; }
        else { const int jj = job - 64, b = jj / 36; kb = jj - b * 36; nkeys = 2304; dst = VS + (size_t)b * 2 * 128 * 2304;
            if (kb < 4) srcf = inp(4) + (size_t)b * 65536 + (size_t)kb * 64 * 256;
            else srcb = QKV + (size_t)(MP + b * 2048 + (kb - 4) * 64) * 1536 + 1280; }
        for (int c = otid(); c < 64 * 32; c += NTHREADS) {
            const int key = c >> 5, c8 = (c & 31) * 8;
            u32x4 v;
            if (srcb) v = *(const u32x4*)(srcb + (size_t)key * 1536 + c8);
            else { const f32x4 a = *(const f32x4*)(srcf + key * 256 + c8), b2 = *(const f32x4*)(srcf + key * 256 + c8 + 4);
                v.x = pk2(a.x, a.y); v.y = pk2(a.z, a.w); v.z = pk2(b2.x, b2.y); v.w = pk2(b2.z, b2.w); }
            *(u32x4*)(vl + key * 264 + c8) = v;
            if (outv) {
                f32x4 a = {bflo(v.x), bfhi(v.x), bflo(v.y), bfhi(v.y)}, b2 = {bflo(v.z), bfhi(v.z), bflo(v.w), bfhi(v.w)};
                *(f32x4*)(outv + key * 256 + c8) = a; *(f32x4*)(outv + key * 256 + c8 + 4) = b2;
            }
        }
        __syncthreads();
        {
            const int rowv = otid() >> 1, half = otid() & 1;
            bf16_t* drow = dst + (size_t)rowv * nkeys + kb * 64 + half * 32;
#pragma unroll
            for (int q = 0; q < 4; ++q) {
                unsigned w[4];
#pragma unroll
                for (int e = 0; e < 4; ++e) {
                    const int k0 = half * 32 + q * 8 + e * 2;
                    w[e] = (unsigned)vl[k0 * 264 + rowv] | ((unsigned)vl[(k0 + 1) * 264 + rowv] << 16);
                }
                *(u32x4*)(drow + q * 8) = (u32x4){w[0], w[1], w[2], w[3]};
            }
        }
        __syncthreads();
    }
}

constexpr int KSTR = 272, VSTR = 144;
constexpr int ATT_KB = 64 * KSTR, ATT_VB = 128 * VSTR, ATT_BUF = ATT_KB + ATT_VB;
DEVI void phase_attn(const Params& p, unsigned char* smem) {
    const bf16_t* Qb = (const bf16_t*)(p.ws + WS_AQ);
    bf16_t* Z = (bf16_t*)(p.ws + WS_Z);
    const int tid = otid(), wave = tid >> 6, lane = tid & 63, fr = lane & 15, fq = lane >> 4;
    for (int u = obid(); u < 512; u += gridDim.x) {
        int h, nkeys, rowbase; const bf16_t* Kbase; const bf16_t* Vbase;
        if (u < 256) { const int b = u >> 7, qb = u & 15; h = (u >> 4) & 7; nkeys = 2304; rowbase = MP + b * 2048 + qb * 128;
            Kbase = (const bf16_t*)(p.ws + WS_AKS) + (size_t)b * 2304 * 256 + (h >> 2) * 128;
            Vbase = (const bf16_t*)(p.ws + WS_AVS) + (size_t)(b * 2 + (h >> 2)) * 128 * 2304; }
        else { const int v = u - 256, b = v >> 4, qb = v & 1; h = (v >> 1) & 7; nkeys = 256; rowbase = b * 256 + qb * 128;
            Kbase = (const bf16_t*)(p.ws + WS_AKP) + (size_t)b * 256 * 256 + (h >> 2) * 128;
            Vbase = (const bf16_t*)(p.ws + WS_AVP) + (size_t)(b * 2 + (h >> 2)) * 128 * 256; }
        const int ntiles = nkeys >> 6;
        bf16x8 qf[4];
        { const bf16_t* qp = Qb + (size_t)(rowbase + wave * 16 + fr) * D + h * 128 + fq * 8;
#pragma unroll
          for (int ks = 0; ks < 4; ++ks) qf[ks] = *(const bf16x8*)(qp + ks * 32); }
        f32x4 o[8];
#pragma unroll
        for (int dt = 0; dt < 8; ++dt) o[dt] = (f32x4){0, 0, 0, 0};
        float mrun = -1e30f, lsum = 0.f;
        const int kr0 = tid >> 4, kc0 = tid & 15;
        const int vr0 = tid >> 3, vc0 = tid & 7;
        u32x4 kreg[2], vreg[2];
#define ATT_LOAD(t) do { \
        kreg[0] = *(const u32x4*)(Kbase + (size_t)((t) * 64 + kr0) * 256 + kc0 * 8); \
        kreg[1] = *(const u32x4*)(Kbase + (size_t)((t) * 64 + kr0 + 32) * 256 + kc0 * 8); \
        vreg[0] = *(const u32x4*)(Vbase + (size_t)vr0 * nkeys + (t) * 64 + vc0 * 8); \
        vreg[1] = *(const u32x4*)(Vbase + (size_t)(vr0 + 64) * nkeys + (t) * 64 + vc0 * 8); } while (0)
#define ATT_STORE(buf) do { unsigned char* kb_ = smem + (buf) * ATT_BUF; unsigned char* vb_ = kb_ + ATT_KB; \
        *(u32x4*)(kb_ + kr0 * KSTR + kc0 * 16) = kreg[0]; *(u32x4*)(kb_ + (kr0 + 32) * KSTR + kc0 * 16) = kreg[1]; \
        *(u32x4*)(vb_ + vr0 * VSTR + vc0 * 16) = vreg[0]; *(u32x4*)(vb_ + (vr0 + 64) * VSTR + vc0 * 16) = vreg[1]; } while (0)
        ATT_LOAD(0); ATT_STORE(0);
        __syncthreads();
        for (int t = 0; t < ntiles; ++t) {
            if (t + 1 < ntiles) ATT_LOAD(t + 1);
            const unsigned char* kb = smem + (t & 1) * ATT_BUF; const unsigned char* vb = kb + ATT_KB;
            f32x4 s[4];
#pragma unroll
            for (int kt = 0; kt < 4; ++kt) {
                s[kt] = (f32x4){0, 0, 0, 0};
#pragma unroll
                for (int ks = 0; ks < 4; ++ks) {
                    const bf16x8 kf = *(const bf16x8*)(kb + (kt * 16 + fr) * KSTR + (ks * 32 + fq * 8) * 2);
                    s[kt] = __builtin_amdgcn_mfma_f32_16x16x32_bf16(kf, qf[ks], s[kt], 0, 0, 0);
                }
            }
            float mx = -1e30f;
#pragma unroll
            for (int kt = 0; kt < 4; ++kt) mx = fmaxf(mx, fmaxf(fmaxf(s[kt].x, s[kt].y), fmaxf(s[kt].z, s[kt].w)));
            mx = fmaxf(mx, __shfl_xor(mx, 16)); mx = fmaxf(mx, __shfl_xor(mx, 32));
            const float mnew = fmaxf(mrun, mx);
            const float alpha = exp2f(mrun - mnew);
            mrun = mnew;
            float ps = 0.f;
#pragma unroll
            for (int kt = 0; kt < 4; ++kt) {
                s[kt].x = exp2f(s[kt].x - mnew); s[kt].y = exp2f(s[kt].y - mnew); s[kt].z = exp2f(s[kt].z - mnew); s[kt].w = exp2f(s[kt].w - mnew);
                ps += (s[kt].x + s[kt].y) + (s[kt].z + s[kt].w);
            }
            lsum = lsum * alpha + ps;
#pragma unroll
            for (int dt = 0; dt < 8; ++dt) o[dt] = o[dt] * alpha;
#pragma unroll
            for (int k2 = 0; k2 < 2; ++k2) {
                u32x4 pw; pw.x = pk2(s[2 * k2].x, s[2 * k2].y); pw.y = pk2(s[2 * k2].z, s[2 * k2].w);
                pw.z = pk2(s[2 * k2 + 1].x, s[2 * k2 + 1].y); pw.w = pk2(s[2 * k2 + 1].z, s[2 * k2 + 1].w);
                const bf16x8 pf = __builtin_bit_cast(bf16x8, pw);
#pragma unroll
                for (int dt = 0; dt < 8; ++dt) {
                    const unsigned char* vp = vb + (dt * 16 + fr) * VSTR + (k2 * 32 + fq * 4) * 2;
                    const u32x2 va = *(const u32x2*)vp, vc = *(const u32x2*)(vp + 32);
                    const u32x4 vw = {va.x, va.y, vc.x, vc.y};
                    o[dt] = __builtin_amdgcn_mfma_f32_16x16x32_bf16(__builtin_bit_cast(bf16x8, vw), pf, o[dt], 0, 0, 0);
                }
            }
            if (t + 1 < ntiles) ATT_STORE((t + 1) & 1);
            __syncthreads();
        }
        lsum += __shfl_xor(lsum, 16); lsum += __shfl_xor(lsum, 32);
        const float inv = 1.f / lsum;
        bf16_t* zp = Z + (size_t)(rowbase + wave * 16 + fr) * D + h * 128 + fq * 4;
#pragma unroll
        for (int dt = 0; dt < 8; ++dt) {
            u32x2 w; w.x = pk2(o[dt].x * inv, o[dt].y * inv); w.y = pk2(o[dt].z * inv, o[dt].w * inv);
            *(u32x2*)(zp + dt * 16) = w;
        }
#undef ATT_LOAD
#undef ATT_STORE
    }
}

constexpr int GLD = 3328;
constexpr int G_R1 = 65536;
constexpr int QK_STR = 136;
constexpr int T_STR = 72;
DEVI void phase_gla_a(const Params& p, unsigned char* smem) {
    const bf16_t* BIGb = (const bf16_t*)(p.ws + WS_BIG);
    bf16_t* GQ = (bf16_t*)(p.ws + WS_GQ);
    bf16_t* GA = (bf16_t*)(p.ws + WS_GA);
    float* GG = (float*)(p.ws + WS_GG);
    bf16_t* GU = (bf16_t*)(p.ws + WS_GU);
    bf16_t* GVT = (bf16_t*)(p.ws + WS_GVT);
    float* bc = (float*)smem;
    unsigned char* r1 = smem + G_R1;
    const int tid = otid(), wave = tid >> 6, lane = tid & 63, fr = lane & 15, fq = lane >> 4;
    for (int unit = obid(); unit < 512; unit += gridDim.x) {
        const int c = unit >> 2, h = unit & 3, r0 = c * 64;
        float* rl = (float*)r1;
        float* w2l = rl + 64 * 33;
        float* bl = w2l + 2 * 16 * 128;
        for (int i = tid; i < 64 * 32; i += NTHREADS) { const int t = i >> 5, q = i & 31; rl[t * 33 + q] = bf2f(BIGb[(size_t)(r0 + t) * GLD + 3072 + q]); }
        for (int i = tid; i < 2 * 16 * 128; i += NTHREADS) { const int dir = i >> 11, rk = (i >> 7) & 15, d = i & 127; w2l[i] = inp(21)[(size_t)(dir * 16 + rk) * 512 + h * 128 + d]; }
        if (tid < 256) { const int dir = tid >> 7, d = tid & 127; bl[tid] = inp(22)[dir * 512 + h * 128 + d]; }
        __syncthreads();
        for (int i = tid; i < 2 * 64 * 128; i += NTHREADS) {
            const int dir = i >> 13, t = (i >> 7) & 63, d = i & 127;
            float z = bl[dir * 128 + d];
#pragma unroll
            for (int q = 0; q < 16; ++q) z += rl[t * 33 + dir * 16 + q] * w2l[(dir * 16 + q) * 128 + d];
            const float ls = fminf(z, 0.f) - log1pf(__expf(-fabsf(z)));
            bc[i] = ls * (1.f / 16.f);
        }
        __syncthreads();
        if (tid < 256) {
            const int dir = tid >> 7, d = tid & 127;
            float run = 0.f;
            if (dir == 0) { for (int t = 0; t < 64; ++t) { run += bc[t * 128 + d]; bc[t * 128 + d] = run; } }
            else { for (int t = 63; t >= 0; --t) { run += bc[8192 + t * 128 + d]; bc[8192 + t * 128 + d] = run; } }
        }
        __syncthreads();
        bf16_t* qk = (bf16_t*)r1;
        for (int i = tid; i < 64 * 16; i += NTHREADS) {
            const int t = i >> 4, d8 = (i & 15) * 8;
            const u32x4 qv = *(const u32x4*)(BIGb + (size_t)(r0 + t) * GLD + h * 128 + d8);
            const u32x4 kv = *(const u32x4*)(BIGb + (size_t)(r0 + t) * GLD + 512 + h * 128 + d8);
            u32x4 oqf, oqb, okf, okb;
#pragma unroll
            for (int q = 0; q < 4; ++q) {
                const float bf0 = bc[t * 128 + d8 + 2 * q], bf1 = bc[t * 128 + d8 + 2 * q + 1];
                const float bb0 = bc[8192 + t * 128 + d8 + 2 * q], bb1 = bc[8192 + t * 128 + d8 + 2 * q + 1];
                const float q0 = bflo(qv[q]) * 0.08838834764831845f, q1 = bfhi(qv[q]) * 0.08838834764831845f;
                const float k0 = bflo(kv[q]), k1 = bfhi(kv[q]);
                oqf[q] = pk2(q0 * __expf(bf0), q1 * __expf(bf1));
                oqb[q] = pk2(q0 * __expf(bb0), q1 * __expf(bb1));
                okf[q] = pk2(k0 * __expf(-bf0), k1 * __expf(-bf1));
                okb[q] = pk2(k0 * __expf(-bb0), k1 * __expf(-bb1));
            }
            *(u32x4*)(qk + (0 * 64 + t) * QK_STR + d8) = oqf;
            *(u32x4*)(qk + (1 * 64 + t) * QK_STR + d8) = oqb;
            *(u32x4*)(qk + (2 * 64 + t) * QK_STR + d8) = okf;
            *(u32x4*)(qk + (3 * 64 + t) * QK_STR + d8) = okb;
            *(u32x4*)(GQ + (size_t)(r0 + t) * 512 + h * 128 + d8) = oqf;
            *(u32x4*)(GQ + (size_t)(MTOK + r0 + t) * 512 + h * 128 + d8) = oqb;
        }
        if (tid < 256) { const int dir = tid >> 7, d = tid & 127;
            GG[(size_t)(unit * 2 + dir) * 128 + d] = __expf(dir == 0 ? bc[63 * 128 + d] : bc[8192 + d]); }
        __syncthreads();
        {
            const int tr = wave & 3;
#pragma unroll
            for (int cc = 0; cc < 2; ++cc) {
                const int tc = (wave >> 2) * 2 + cc;
                f32x4 af = {0, 0, 0, 0}, ab = {0, 0, 0, 0};
#pragma unroll
                for (int ks = 0; ks < 4; ++ks) {
                    const bf16x8 qf_ = *(const bf16x8*)(qk + (0 * 64 + tr * 16 + fr) * QK_STR + ks * 32 + fq * 8);
                    const bf16x8 qb_ = *(const bf16x8*)(qk + (1 * 64 + tr * 16 + fr) * QK_STR + ks * 32 + fq * 8);
                    const bf16x8 kf_ = *(const bf16x8*)(qk + (2 * 64 + tc * 16 + fr) * QK_STR + ks * 32 + fq * 8);
                    const bf16x8 kb_ = *(const bf16x8*)(qk + (3 * 64 + tc * 16 + fr) * QK_STR + ks * 32 + fq * 8);
                    af = __builtin_amdgcn_mfma_f32_16x16x32_bf16(kf_, qf_, af, 0, 0, 0);
                    ab = __builtin_amdgcn_mfma_f32_16x16x32_bf16(kb_, qb_, ab, 0, 0, 0);
                }
                const int t = tr * 16 + fr, s0 = tc * 16 + fq * 4;
                float a[4];
#pragma unroll
                for (int j = 0; j < 4; ++j) { const int s = s0 + j; a[j] = (t >= s ? af[j] : 0.f) + (s >= t ? ab[j] : 0.f); }
                u32x2 w; w.x = pk2(a[0], a[1]); w.y = pk2(a[2], a[3]);
                *(u32x2*)(GA + ((size_t)unit * 64 + t) * 64 + s0) = w;
            }
        }
        __syncthreads();
        bf16_t* khT = (bf16_t*)r1;
        bf16_t* vT = khT + 2 * 128 * T_STR;
        for (int i = tid; i < 64 * 16; i += NTHREADS) {
            const int s = i & 63, d8 = (i >> 6) * 8;
            const u32x4 kv = *(const u32x4*)(BIGb + (size_t)(r0 + s) * GLD + 512 + h * 128 + d8);
#pragma unroll
            for (int q = 0; q < 8; ++q) {
                const int d = d8 + q;
                const float k = (q & 1) ? bfhi(kv[q >> 1]) : bflo(kv[q >> 1]);
                const float ef = __expf(bc[63 * 128 + d] - bc[s * 128 + d]);
                const float eb = __expf(bc[8192 + d] - bc[8192 + s * 128 + d]);
                khT[(0 * 128 + d) * T_STR + s] = (bf16_t)(pk2(k * ef, 0.f) & 0xffff);
                khT[(1 * 128 + d) * T_STR + s] = (bf16_t)(pk2(k * eb, 0.f) & 0xffff);
            }
        }
        for (int i = tid; i < 64 * 32; i += NTHREADS) {
            const int s = i & 63, e8 = (i >> 6) * 8;
            const u32x4 vv = *(const u32x4*)(BIGb + (size_t)(r0 + s) * GLD + 1024 + h * 256 + e8);
#pragma unroll
            for (int q = 0; q < 4; ++q) { vT[(e8 + 2 * q) * T_STR + s] = (bf16_t)(vv[q] & 0xffff); vT[(e8 + 2 * q + 1) * T_STR + s] = (bf16_t)(vv[q] >> 16); }
        }
        __syncthreads();
        for (int i = tid; i < 256 * 8; i += NTHREADS) {
            const int e = i >> 3, cch = i & 7;
            *(u32x4*)(GVT + ((size_t)unit * 256 + e) * 64 + cch * 8) = *(const u32x4*)(vT + e * T_STR + cch * 8);
        }
        {
            const int dir = wave >> 2;
            bf16_t* Uo = GU + (size_t)(unit * 2 + dir) * 256 * 128;
#pragma unroll 1
            for (int eh = 0; eh < 2; ++eh) {
                f32x4 acc[2][8];
#pragma unroll
                for (int a = 0; a < 2; ++a)
#pragma unroll
                    for (int b = 0; b < 8; ++b) acc[a][b] = (f32x4){0, 0, 0, 0};
#pragma unroll
                for (int ks = 0; ks < 2; ++ks) {
                    bf16x8 af[2];
#pragma unroll
                    for (int a = 0; a < 2; ++a) af[a] = *(const bf16x8*)(khT + (dir * 128 + ((wave & 3) * 2 + a) * 16 + fr) * T_STR + ks * 32 + fq * 8);
#pragma unroll
                    for (int b = 0; b < 8; ++b) {
                        const bf16x8 bfv = *(const bf16x8*)(vT + ((eh * 8 + b) * 16 + fr) * T_STR + ks * 32 + fq * 8);
#pragma unroll
                        for (int a = 0; a < 2; ++a) acc[a][b] = __builtin_amdgcn_mfma_f32_16x16x32_bf16(af[a], bfv, acc[a][b], 0, 0, 0);
                    }
                }
#pragma unroll
                for (int a = 0; a < 2; ++a)
#pragma unroll
                    for (int b = 0; b < 8; ++b) {
                        const int d0 = ((wave & 3) * 2 + a) * 16 + fq * 4, e = (eh * 8 + b) * 16 + fr;
                        u32x2 w; w.x = pk2(acc[a][b].x, acc[a][b].y); w.y = pk2(acc[a][b].z, acc[a][b].w);
                        *(u32x2*)(Uo + (size_t)e * 128 + d0) = w;
                    }
            }
        }
        __syncthreads();
    }
}

DEVI void phase_gla_scan(const Params& p) {
    bf16_t* GU = (bf16_t*)(p.ws + WS_GU);
    const float* GG = (const float*)(p.ws + WS_GG);
    const int T = gridDim.x * NTHREADS;
    for (int id = obid() * NTHREADS + otid(); id < 65536 + 524288; id += T) {
        int b, h, dir, e, d8, nc, c0; bool sample = id < 65536;
        int v = sample ? id : id - 65536;
        d8 = (v & 15) * 8; e = (v >> 4) & 255; dir = (v >> 12) & 1; h = (v >> 13) & 3; b = v >> 15;
        if (sample) { nc = 32; c0 = 64 + b * 32; } else { nc = 4; c0 = b * 4; }
        float run[8];
        if (sample) {
            const float* s0f = inp(5); const float* s0b = inp(6);
            const float* s0 = (dir == 0 ? s0f : s0b) + (size_t)(b * 4 + h) * 32768 + e;
#pragma unroll
            for (int q = 0; q < 8; ++q) run[q] = s0[(size_t)(d8 + q) * 256];
        } else {
#pragma unroll
            for (int q = 0; q < 8; ++q) run[q] = 0.f;
        }
        for (int i = 0; i < nc; ++i) {
            const int cs = dir == 0 ? i : nc - 1 - i;
            const int unit = (c0 + cs) * 4 + h;
            bf16_t* up = GU + ((size_t)(unit * 2 + dir) * 256 + e) * 128 + d8;
            const float* gp = GG + (size_t)(unit * 2 + dir) * 128 + d8;
            const u32x4 uv = *(const u32x4*)up;
            const f32x4 g0 = *(const f32x4*)gp, g1 = *(const f32x4*)(gp + 4);
            u32x4 sv; sv.x = pk2(run[0], run[1]); sv.y = pk2(run[2], run[3]); sv.z = pk2(run[4], run[5]); sv.w = pk2(run[6], run[7]);
            *(u32x4*)up = sv;
            run[0] = g0.x * run[0] + bflo(uv.x); run[1] = g0.y * run[1] + bfhi(uv.x);
            run[2] = g0.z * run[2] + bflo(uv.y); run[3] = g0.w * run[3] + bfhi(uv.y);
            run[4] = g1.x * run[4] + bflo(uv.z); run[5] = g1.y * run[5] + bfhi(uv.z);
            run[6] = g1.z * run[6] + bflo(uv.w); run[7] = g1.w * run[7] + bfhi(uv.w);
        }
        if (!sample) {
            float* o = p.out + (dir == 0 ? OUT_SF : OUT_SB) + (size_t)(b * 4 + h) * 32768 + e;
#pragma unroll
            for (int q = 0; q < 8; ++q) o[(size_t)(d8 + q) * 256] = run[q];
        }
    }
}

constexpr int AOP_STR = 328;
DEVI void phase_gla_c(const Params& p, unsigned char* smem) {
    const bf16_t* BIGb = (const bf16_t*)(p.ws + WS_BIG);
    const bf16_t* GQ = (const bf16_t*)(p.ws + WS_GQ);
    const bf16_t* GA = (const bf16_t*)(p.ws + WS_GA);
    const bf16_t* GU = (const bf16_t*)(p.ws + WS_GU);
    const bf16_t* GVT = (const bf16_t*)(p.ws + WS_GVT);
    bf16_t* Z = (bf16_t*)(p.ws + WS_Z);
    const float* ng = inp(23);
    bf16_t* aop = (bf16_t*)smem;
    float* red = (float*)(smem + 64 * AOP_STR * 2);
    const int tid = otid(), wave = tid >> 6, lane = tid & 63, fr = lane & 15, fq = lane >> 4;
    for (int unit = obid(); unit < 512; unit += gridDim.x) {
        const int c = unit >> 2, h = unit & 3, r0 = c * 64;
        for (int i = tid; i < 64 * 40; i += NTHREADS) {
            const int t = i / 40, ch = i - t * 40;
            u32x4 v;
            if (ch < 8) v = *(const u32x4*)(GA + ((size_t)unit * 64 + t) * 64 + ch * 8);
            else if (ch < 24) v = *(const u32x4*)(GQ + (size_t)(r0 + t) * 512 + h * 128 + (ch - 8) * 8);
            else v = *(const u32x4*)(GQ + (size_t)(MTOK + r0 + t) * 512 + h * 128 + (ch - 24) * 8);
            *(u32x4*)(aop + t * AOP_STR + ch * 8) = v;
        }
        __syncthreads();
        f32x4 acc[2][4];
#pragma unroll
        for (int a = 0; a < 2; ++a)
#pragma unroll
            for (int b = 0; b < 4; ++b) acc[a][b] = (f32x4){0, 0, 0, 0};
#pragma unroll
        for (int ks = 0; ks < 10; ++ks) {
            bf16x8 ef[2];
#pragma unroll
            for (int a = 0; a < 2; ++a) {
                const int e = (wave * 2 + a) * 16 + fr;
                const bf16_t* src;
                if (ks < 2) src = GVT + ((size_t)unit * 256 + e) * 64 + ks * 32 + fq * 8;
                else if (ks < 6) src = GU + ((size_t)(unit * 2 + 0) * 256 + e) * 128 + (ks - 2) * 32 + fq * 8;
                else src = GU + ((size_t)(unit * 2 + 1) * 256 + e) * 128 + (ks - 6) * 32 + fq * 8;
                ef[a] = *(const bf16x8*)src;
            }
#pragma unroll
            for (int b = 0; b < 4; ++b) {
                const bf16x8 tf = *(const bf16x8*)(aop + (b * 16 + fr) * AOP_STR + ks * 32 + fq * 8);
#pragma unroll
                for (int a = 0; a < 2; ++a) acc[a][b] = __builtin_amdgcn_mfma_f32_16x16x32_bf16(ef[a], tf, acc[a][b], 0, 0, 0);
            }
        }
#pragma unroll
        for (int b = 0; b < 4; ++b) {
            float ss = 0.f;
#pragma unroll
            for (int a = 0; a < 2; ++a) ss += (acc[a][b].x * acc[a][b].x + acc[a][b].y * acc[a][b].y) + (acc[a][b].z * acc[a][b].z + acc[a][b].w * acc[a][b].w);
            ss += __shfl_xor(ss, 16); ss += __shfl_xor(ss, 32);
            if (fq == 0) red[wave * 64 + b * 16 + fr] = ss;
        }
        __syncthreads();
#pragma unroll
        for (int b = 0; b < 4; ++b) {
            const int t = b * 16 + fr;
            float tot = 0.f;
#pragma unroll
            for (int w = 0; w < 8; ++w) tot += red[w * 64 + t];
            const float rstd = rsqrtf(tot * (1.f / 256.f) + 1e-6f);
#pragma unroll
            for (int a = 0; a < 2; ++a) {
                const int e0 = (wave * 2 + a) * 16 + fq * 4;
                const u32x2 ogv = *(const u32x2*)(BIGb + (size_t)(r0 + t) * GLD + 2048 + h * 256 + e0);
                const f32x4 g = *(const f32x4*)(ng + e0);
                const float o0 = acc[a][b].x * rstd * g.x * silu_f(bflo(ogv.x));
                const float o1 = acc[a][b].y * rstd * g.y * silu_f(bfhi(ogv.x));
                const float o2 = acc[a][b].z * rstd * g.z * silu_f(bflo(ogv.y));
                const float o3 = acc[a][b].w * rstd * g.w * silu_f(bfhi(ogv.y));
                u32x2 w; w.x = pk2(o0, o1); w.y = pk2(o2, o3);
                *(u32x2*)(Z + (size_t)(r0 + t) * D + h * 256 + e0) = w;
            }
        }
        __syncthreads();
    }
}

#define XB_TMO      128
#define XB_XCNT(j)  (256  + 64 * (j))
#define XB_XSUB(j)  (1280 + 64 * (j))
#define XB_XGEN(j)  (2304 + 64 * (j))
#define XB_TOP      3328
#define XB_TOPGEN   3392
#define XCD_BAR_WORDS 3456
#define XB_SPIN_CAP (1u << 18)
#define XLAS __attribute__((address_space(3)))

__device__ __forceinline__ unsigned xb_ld(unsigned* p)              { return __hip_atomic_load(p, __ATOMIC_RELAXED, __HIP_MEMORY_SCOPE_AGENT); }
__device__ __forceinline__ unsigned xb_add(unsigned* p, unsigned v) { return __hip_atomic_fetch_add(p, v, __ATOMIC_RELAXED, __HIP_MEMORY_SCOPE_AGENT); }
__device__ __forceinline__ unsigned xb_xcc_id() { return (unsigned)__builtin_amdgcn_s_getreg((3 << 11) | 20) & 0xFu; }
#define XB_SPIN(cond, bar) do { unsigned _sp = 0; while (cond) { __builtin_amdgcn_s_sleep(1); \
    if ((++_sp & 255u) == 0u) { if (xb_ld(&(bar)[XB_TMO])) break; if (_sp > XB_SPIN_CAP) { atomicAdd(&(bar)[XB_TMO], 1u); break; } } } } while (0)

struct XcdBarrier {
    unsigned* bar; unsigned x;
    volatile XLAS unsigned* st;
};

__device__ __forceinline__ XcdBarrier xcd_barrier_post(unsigned* bar, volatile XLAS unsigned* st) {
    XcdBarrier b; b.bar = bar; b.x = xb_xcc_id(); b.st = st;
    if (threadIdx.x == 0) (void)xb_add(&bar[XB_XCNT(b.x)], 1u);
    return b;
}
__device__ __forceinline__ void xcd_barrier_complete(unsigned* bar, unsigned x, unsigned& nloc, unsigned& nx) {
    const unsigned G = gridDim.x * gridDim.y * gridDim.z;
    unsigned sum, cnt, mine, sp = 0u;
    for (;;) {
        sum = 0u; cnt = 0u; mine = 0u;
#pragma unroll
        for (unsigned j = 0; j < 16; ++j) { const unsigned c = xb_ld(&bar[XB_XCNT(j)]); sum += c; cnt += (c > 0u) ? 1u : 0u; mine = (j == x) ? c : mine; }
        if (sum == G) break;
        __builtin_amdgcn_s_sleep(1);
        if ((++sp & 255u) == 0u) { if (xb_ld(&bar[XB_TMO])) break; if (sp > XB_SPIN_CAP) { atomicAdd(&bar[XB_TMO], 1u); break; } }
    }
    nloc = mine > 0u ? mine : 1u; nx = cnt > 0u ? cnt : 1u;
}

__device__ __forceinline__ void xcd_barrier(const XcdBarrier& b) {
    asm volatile("s_waitcnt vmcnt(0)" ::: "memory");
    __syncthreads();
    if (threadIdx.x == 0) {
        unsigned* bar = b.bar;
        __builtin_amdgcn_s_waitcnt(0);
        unsigned nloc = b.st[0], nx = b.st[1];
        if (nloc == 0u) { xcd_barrier_complete(bar, b.x, nloc, nx); b.st[0] = nloc; b.st[1] = nx; }
        const unsigned old = xb_add(&bar[XB_XSUB(b.x)], 1u);
        const unsigned gen = old / nloc;
        if (old + 1u == (gen + 1u) * nloc) {
            __builtin_amdgcn_fence(__ATOMIC_RELEASE, "agent");
            asm volatile("s_waitcnt vmcnt(0)" ::: "memory");
            const unsigned og = xb_add(&bar[XB_TOP], 1u);
            const unsigned tg = og / nx;
            if (og + 1u == (tg + 1u) * nx) xb_add(&bar[XB_TOPGEN], 1u);
            else XB_SPIN(xb_ld(&bar[XB_TOPGEN]) == tg, bar);
            __builtin_amdgcn_fence(__ATOMIC_ACQUIRE, "agent");
            xb_add(&bar[XB_XGEN(b.x)], 1u);
            asm volatile("s_waitcnt vmcnt(0)" ::: "memory");
        } else {
            XB_SPIN(xb_ld(&bar[XB_XGEN(b.x)]) == gen, bar);
            __builtin_amdgcn_fence(__ATOMIC_ACQUIRE, "agent");
            asm volatile("s_waitcnt vmcnt(0)" ::: "memory");
        }
    }
    __syncthreads();
}

template <class Epi>
DEVI void run_gemm(unsigned char* smem, const bf16_t* A, const bf16_t* Bt, int N, int K, const Epi& E) {
    pg8::Gemm g{A, Bt, MTOK, N, K};
    pg8::StaticOrder S; S.init(MTOK, N, (int)gridDim.x, obid());
    pg8::gemm_phase<Epi, pg8::StaticOrder, true, true>((PG8_LAS unsigned char*)smem, g, S, E);
}

__global__ void __launch_bounds__(NTHREADS) mega_fwd(Params p) {
    extern __shared__ __attribute__((aligned(16))) unsigned char smem[];
    volatile XLAS unsigned* xst = (volatile XLAS unsigned*)(XLAS unsigned char*)(smem + LDS_PHASE);
    if (threadIdx.x == 0) { xst[0] = 0u; xst[1] = 0u; xst[2] = 0u; xst[3] = 0u; }
    __syncthreads();
    const XcdBarrier xbar = xcd_barrier_post((unsigned*)(p.ws + WS_BAR), xst);
    if (p.ws == nullptr) cg::this_grid().sync();
#define GSYNC() do { xcd_barrier(xbar); } while (0)

    phase_prep(p, smem);
    GSYNC();
    phase_modfinal(p);
    GSYNC();
    phase_rows<0>(p, nullptr, nullptr, (const float*)(p.ws + WS_MOD), 0, 1, false);
    GSYNC();
#ifndef DBG_LAYERS
#define DBG_LAYERS 4
#endif
#pragma unroll 1
    for (int l = 0; l < DBG_LAYERS; ++l) {
        const int kind = l % 3, j = l / 3;
        {
            const bf16_t* Win; int Nin;
            if (kind == 0) { Win = (const bf16_t*)(p.ws + WS_WCIN) + (size_t)j * 3072 * 1024; Nin = 3072; }
            else if (kind == 1) { Win = (const bf16_t*)(p.ws + WS_WQKV); Nin = 1536; }
            else { Win = (const bf16_t*)(p.ws + WS_WGIN); Nin = 3328; }
            pg8::EpiStore E{(bf16_t*)(p.ws + WS_BIG), Nin};
            run_gemm(smem, (const bf16_t*)(p.ws + WS_H), Win, Nin, 1024, E);
        }
        GSYNC();
        if (kind == 0) { phase_conv(p, j); }
        else if (kind == 1) { phase_attn_prep(p, smem); GSYNC(); phase_attn(p, smem); }
        else { phase_gla_a(p, smem); GSYNC(); phase_gla_scan(p); GSYNC(); phase_gla_c(p, smem); }
        GSYNC();
        {
            const bf16_t* Wout;
            if (kind == 0) Wout = (const bf16_t*)(p.ws + WS_WCOUT) + (size_t)j * 1024 * 1024;
            else if (kind == 1) Wout = (const bf16_t*)(p.ws + WS_WAO);
            else Wout = (const bf16_t*)(p.ws + WS_WGO);
            pg8::EpiResid E{(float*)(p.ws + WS_X), (const float*)(p.ws + WS_MOD) + (size_t)l * 3 * 6144 + 2 * 1024};
            run_gemm(smem, (const bf16_t*)(p.ws + WS_Z), Wout, 1024, 1024, E);
        }
        GSYNC();
        phase_rows<1>(p, inp(10) + (size_t)(l * 2 + 0) * D, inp(11) + (size_t)(l * 2 + 0) * D, (const float*)(p.ws + WS_MOD) + (size_t)l * 3 * 6144, 3, 4, false);
        GSYNC();
        {
            pg8::EpiSwiglu E{(bf16_t*)(p.ws + WS_BIG), DFF};
            run_gemm(smem, (const bf16_t*)(p.ws + WS_H), (const bf16_t*)(p.ws + WS_WFIN) + (size_t)l * 5632 * 1024, 5632, 1024, E);
        }
        GSYNC();
        {
            pg8::EpiResid E{(float*)(p.ws + WS_X), (const float*)(p.ws + WS_MOD) + (size_t)l * 3 * 6144 + 5 * 1024};
            run_gemm(smem, (const bf16_t*)(p.ws + WS_BIG), (const bf16_t*)(p.ws + WS_WFOUT) + (size_t)l * 1024 * 2816, 1024, 2816, E);
        }
        GSYNC();
        phase_rows<1>(p, inp(10) + (size_t)(l * 2 + 1) * D, inp(11) + (size_t)(l * 2 + 1) * D,
                      l < 3 ? (const float*)(p.ws + WS_MOD) + (size_t)(l + 1) * 3 * 6144 : nullptr, 0, 1, l == DBG_LAYERS - 1);
        GSYNC();
    }
}

extern "C" void kernel_launch(void* const* d_in, const int* in_sizes, int n_in, void* d_out, int out_size, void* d_ws, size_t ws_size, hipStream_t stream) {
    static int grid_blocks = 0;
    if (grid_blocks == 0) {
        if (n_in != 27 || ws_size < WS_TOTAL) { fprintf(stderr, "kernel_launch: unexpected n_in %d or ws_size %zu (< %zu)\n", n_in, ws_size, (size_t)WS_TOTAL); grid_blocks = -1; return; }
        int dev = 0, cus = 0, per_cu = 0;
        hipGetDevice(&dev);
        hipDeviceGetAttribute(&cus, hipDeviceAttributeMultiprocessorCount, dev);
        hipFuncSetAttribute((const void*)mega_fwd, hipFuncAttributeMaxDynamicSharedMemorySize, LDS_BYTES);
        hipOccupancyMaxActiveBlocksPerMultiprocessor(&per_cu, (const void*)mega_fwd, NTHREADS, LDS_BYTES);
        if (per_cu < 1) per_cu = 1;
        grid_blocks = cus * 1;
        (void)hipGetLastError();
    }
    if (grid_blocks < 0) return;
    if (hipMemsetAsync((char*)d_ws + WS_BAR, 0, 16384, stream) != hipSuccess) { fprintf(stderr, "kernel_launch: memset of barrier words failed\n"); return; }
    Params p{};
    for (int i = 0; i < 27; ++i) p.in[i] = (const float*)d_in[i];
    p.out = (float*)d_out; p.ws = (unsigned char*)d_ws;
    void* args[] = {&p};
    hipError_t e = hipLaunchCooperativeKernel((const void*)mega_fwd, dim3(grid_blocks), dim3(NTHREADS), args, LDS_BYTES, stream);
    if (e != hipSuccess) fprintf(stderr, "cooperative launch failed: %s (grid %d)\n", hipGetErrorString(e), grid_blocks);
}
#ifdef PHASE_TEST
__global__ void __launch_bounds__(NTHREADS) t_gemm0(Params p, int N) { extern __shared__ __attribute__((aligned(16))) unsigned char smem[]; pg8::EpiStore E{(bf16_t*)(p.ws + WS_BIG), N}; run_gemm(smem, (const bf16_t*)(p.ws + WS_H), (const bf16_t*)(p.ws + WS_WCIN), N, 1024, E); }
__global__ void __launch_bounds__(NTHREADS) t_gemm1(Params p) { extern __shared__ __attribute__((aligned(16))) unsigned char smem[]; pg8::EpiSwiglu E{(bf16_t*)(p.ws + WS_BIG), DFF}; run_gemm(smem, (const bf16_t*)(p.ws + WS_H), (const bf16_t*)(p.ws + WS_WFIN), 5632, 1024, E); }
__global__ void __launch_bounds__(NTHREADS) t_gemm2(Params p, int K) { extern __shared__ __attribute__((aligned(16))) unsigned char smem[]; pg8::EpiResid E{(float*)(p.ws + WS_X), (const float*)(p.ws + WS_MOD)}; run_gemm(smem, (const bf16_t*)(p.ws + WS_Z), (const bf16_t*)(p.ws + WS_WCOUT), 1024, K, E); }
#endif
```

```cpp
#include <hip/hip_runtime.h>
#include <hip/hip_cooperative_groups.h>
#include <cstdio>
#include <cstdint>
namespace cg = cooperative_groups;

typedef unsigned short bf16_t;
typedef short bf16x8 __attribute__((ext_vector_type(8)));
typedef float f32x4 __attribute__((ext_vector_type(4)));
typedef unsigned u32x4 __attribute__((ext_vector_type(4)));
typedef unsigned u32x2 __attribute__((ext_vector_type(2)));
#define DEVI __device__ __forceinline__

constexpr int D = 1024, MTOK = 8192, MP = 4096, DFF = 2816;
constexpr float ALPHA = 1.6817928305074290f;
constexpr int NTHREADS = 512;
constexpr int LDS_PHASE = 139264;
constexpr int LDS_BYTES = LDS_PHASE + 16;

constexpr size_t WS_WCIN  = 0;
constexpr size_t WS_WCOUT = WS_WCIN  + 2ull * 3072 * 1024 * 2;
constexpr size_t WS_WQKV  = WS_WCOUT + 2ull * 1024 * 1024 * 2;
constexpr size_t WS_WAO   = WS_WQKV  + 1536ull * 1024 * 2;
constexpr size_t WS_WGIN  = WS_WAO   + 1024ull * 1024 * 2;
constexpr size_t WS_WGO   = WS_WGIN  + 3328ull * 1024 * 2;
constexpr size_t WS_WFIN  = WS_WGO   + 1024ull * 1024 * 2;
constexpr size_t WS_WFOUT = WS_WFIN  + 4ull * 5632 * 1024 * 2;
constexpr size_t WS_MODP  = WS_WFOUT + 4ull * 1024 * 2816 * 2;
constexpr size_t WS_MOD   = WS_MODP  + 32ull * 4 * 3 * 6144 * 4;
constexpr size_t WS_X     = WS_MOD   + 4ull * 3 * 6144 * 4;
constexpr size_t WS_H     = WS_X     + 8192ull * 1024 * 4;
constexpr size_t WS_BIG   = WS_H     + 8192ull * 1024 * 2;
constexpr size_t WS_Z     = WS_BIG   + 8192ull * 3328 * 2;
constexpr size_t WS_GQ    = WS_Z     + 8192ull * 1024 * 2;
constexpr size_t WS_GA    = WS_GQ    + 2ull * 8192 * 512 * 2;
constexpr size_t WS_GG    = WS_GA    + 512ull * 64 * 64 * 2;
constexpr size_t WS_GU    = WS_GG    + 1024ull * 128 * 4;
constexpr size_t WS_END   = WS_GU    + 1024ull * 256 * 128 * 2;
constexpr size_t WS_BAR   = WS_END;
constexpr size_t WS_TOTAL = WS_BAR + 16384;
constexpr size_t WS_GVT   = WS_H;
constexpr size_t WS_AQ    = WS_BIG + 8192ull * 1536 * 2;
constexpr size_t WS_AKP   = WS_AQ  + 8192ull * 1024 * 2;
constexpr size_t WS_AKS   = WS_AKP + 16ull * 256 * 256 * 2;
constexpr size_t WS_AVP   = WS_AKS + 2ull * 2304 * 256 * 2;
constexpr size_t WS_AVS   = WS_AVP + 16ull * 2 * 128 * 256 * 2;
static_assert(WS_AVS + 2ull * 2 * 128 * 2304 * 2 <= WS_Z, "attention buffers overflow BIG");

constexpr size_t OUT_Y = 0, OUT_CK = 8388608, OUT_CV = 9437184, OUT_SF = 10485760, OUT_SB = 12582912;

struct Params {
    const float* in[27];
    float* out;
    unsigned char* ws;
};
__device__ __forceinline__ int otid() { int t = threadIdx.x; asm volatile("" : "+v"(t)); return t; }
__device__ __forceinline__ int obid() { int b = blockIdx.x; asm volatile("" : "+s"(b)); return b; }
__device__ __forceinline__ const float* inp(int i) {
    const float* const* ka = (const float* const*)__builtin_amdgcn_kernarg_segment_ptr();
    asm volatile("" : "+s"(i));
    return ka[i];
}

typedef float f32x2_t __attribute__((ext_vector_type(2)));
typedef __bf16 bf16x2_t __attribute__((ext_vector_type(2)));
DEVI unsigned pk2(float lo, float hi) { f32x2_t v = {lo, hi}; bf16x2_t b = __builtin_convertvector(v, bf16x2_t); return __builtin_bit_cast(unsigned, b); }
DEVI float bflo(unsigned u) { return __uint_as_float(u << 16); }
DEVI float bfhi(unsigned u) { return __uint_as_float(u & 0xffff0000u); }
DEVI float bf2f(bf16_t u) { return __uint_as_float(((unsigned)u) << 16); }
DEVI float silu_f(float x) { return x * __builtin_amdgcn_rcpf(1.f + __expf(-x)); }
DEVI float wave_sum(float v) {
#pragma unroll
    for (int o = 1; o < 64; o <<= 1) v += __shfl_xor(v, o);
    return v;
}
DEVI int row_cond(int row) { return row < MP ? 0 : 1 + ((row - MP) >> 11); }

struct TJob { int in_idx, src_off, K, N, map, row_off, dst_ld; unsigned dst_off; };
__device__ const TJob g_jobs[18] = {
    {12, 0,               1024, 3072, 0, 0, 1024, (unsigned)WS_WCIN},
    {14, 0,               1024, 1024, 0, 0, 1024, (unsigned)WS_WCOUT},
    {25, 0,               1024, 5632, 1, 0, 1024, (unsigned)WS_WFIN},
    {26, 0,               2816, 1024, 0, 0, 2816, (unsigned)WS_WFOUT},
    {15, 0,               1024, 1536, 0, 0, 1024, (unsigned)WS_WQKV},
    {18, 0,               1024, 1024, 0, 0, 1024, (unsigned)WS_WAO},
    {25, 1024 * 5632,     1024, 5632, 1, 0, 1024, (unsigned)(WS_WFIN + 1ull * 5632 * 1024 * 2)},
    {26, 2816 * 1024,     2816, 1024, 0, 0, 2816, (unsigned)(WS_WFOUT + 1ull * 1024 * 2816 * 2)},
    {19, 0,               1024, 3072, 0, 0, 1024, (unsigned)WS_WGIN},
    {24, 0,               1024, 1024, 0, 0, 1024, (unsigned)WS_WGO},
    {25, 2 * 1024 * 5632, 1024, 5632, 1, 0, 1024, (unsigned)(WS_WFIN + 2ull * 5632 * 1024 * 2)},
    {26, 2 * 2816 * 1024, 2816, 1024, 0, 0, 2816, (unsigned)(WS_WFOUT + 2ull * 1024 * 2816 * 2)},
    {20, 0,               1024, 16,   0, 3072, 1024, (unsigned)WS_WGIN},
    {20, 1024 * 16,       1024, 16,   0, 3088, 1024, (unsigned)WS_WGIN},
    {12, 1024 * 3072,     1024, 3072, 0, 0, 1024, (unsigned)(WS_WCIN + 3072ull * 1024 * 2)},
    {14, 1024 * 1024,     1024, 1024, 0, 0, 1024, (unsigned)(WS_WCOUT + 1024ull * 1024 * 2)},
    {25, 3 * 1024 * 5632, 1024, 5632, 1, 0, 1024, (unsigned)(WS_WFIN + 3ull * 5632 * 1024 * 2)},
    {26, 3 * 2816 * 1024, 2816, 1024, 0, 0, 2816, (unsigned)(WS_WFOUT + 3ull * 1024 * 2816 * 2)},
};
constexpr int N_MODJOBS = 384;
constexpr int N_MODPART = 32;

DEVI void transpose_item(const float* W, int K, int N, int map, bf16_t* dst, int dst_ld, int row_off, int item, float* tl) {
    const int nb = (N + 63) >> 6;
    const int kb = item / nb, nbi = item - kb * nb, k0 = kb * 64, n0 = nbi * 64;
    const int tid = otid();
    {
        const int c = tid & 63, r = tid >> 6, n = n0 + c;
#pragma unroll
        for (int i = 0; i < 8; ++i) { const int kk = r + 8 * i; tl[kk * 65 + c] = (n < N) ? W[(size_t)(k0 + kk) * N + n] : 0.f; }
    }
    __syncthreads();
    {
        const int kp = tid & 31, nr = tid >> 5;
#pragma unroll
        for (int i = 0; i < 4; ++i) {
            const int nl = nr + 16 * i, n = n0 + nl;
            if (n < N) {
                const float a = tl[(2 * kp) * 65 + nl], b = tl[(2 * kp + 1) * 65 + nl];
                *(unsigned*)(dst + (size_t)(row_off + n) * dst_ld + k0 + 2 * kp) = pk2(a, b);
            }
        }
    }
    __syncthreads();
}

constexpr int TL_STR = 260;
DEVI void transpose_strip(const float* W, int K, int N, int map, bf16_t* dst, int dst_ld, int strip, float* tl) {
    const int nb = N >> 8;
    const int kb = strip / nb, nbi = strip - kb * nb, k0 = kb * 64, n0 = nbi * 256;
    const int tid = otid();
    {
        const int c4 = tid & 63, r = tid >> 6;
        f32x4 v[8];
#pragma unroll
        for (int i = 0; i < 8; ++i) v[i] = *(const f32x4*)(W + (size_t)(k0 + r + 8 * i) * N + n0 + c4 * 4);
#pragma unroll
        for (int i = 0; i < 8; ++i) *(f32x4*)(tl + (r + 8 * i) * TL_STR + c4 * 4) = v[i];
    }
    __syncthreads();
    {
        const int nl = tid & 255, kh = tid >> 8, n = n0 + nl;
        int np = n;
        if (map == 1) np = (n < DFF) ? (256 * (n >> 7) + (n & 127)) : (256 * ((n - DFF) >> 7) + 128 + ((n - DFF) & 127));
        bf16_t* drow = dst + (size_t)np * dst_ld + k0 + kh * 32;
#pragma unroll
        for (int c = 0; c < 4; ++c) {
            const float* s = tl + (kh * 32 + c * 8) * TL_STR + nl;
            u32x4 o; o.x = pk2(s[0], s[TL_STR]); o.y = pk2(s[2 * TL_STR], s[3 * TL_STR]); o.z = pk2(s[4 * TL_STR], s[5 * TL_STR]); o.w = pk2(s[6 * TL_STR], s[7 * TL_STR]);
            *(u32x4*)(drow + c * 8) = o;
        }
    }
    __syncthreads();
}

DEVI void mod_job(const Params& p, int job, float* sl) {
    const int sixth = job % 6, lk = job / 6, kc = lk & 15, l = lk >> 4;
    const int tid = otid();
    if (tid < 192) {
        const int c = tid >> 6, kk = tid & 63, k = kc * 64 + kk;
        const float x = (c == 0) ? inp(7)[k] : inp(2)[(c - 1) * 1024 + k];
        sl[c * 64 + kk] = silu_f(x);
    }
    __syncthreads();
    const int kh = tid >> 8, n0 = sixth * 1024 + (tid & 255) * 4;
    const float* W = inp(8) + (size_t)l * 1024 * 6144 + (size_t)(kc * 64 + kh * 32) * 6144 + n0;
    f32x4 a0 = {0, 0, 0, 0}, a1 = a0, a2 = a0;
#pragma unroll 8
    for (int kk = 0; kk < 32; ++kk) {
        const f32x4 w = *(const f32x4*)(W + (size_t)kk * 6144);
        a0 += w * sl[kh * 32 + kk]; a1 += w * sl[64 + kh * 32 + kk]; a2 += w * sl[128 + kh * 32 + kk];
    }
    float* P = (float*)(p.ws + WS_MODP) + (size_t)(((kc * 2 + kh) * 4 + l) * 3) * 6144 + n0;
    *(f32x4*)(P) = a0; *(f32x4*)(P + 6144) = a1; *(f32x4*)(P + 2 * 6144) = a2;
    __syncthreads();
}

DEVI void prep_layer(const Params& p, int layer, int brel, int nblk, unsigned char* smem) {
    float* tl = (float*)smem;
    const int j0 = layer == 0 ? 0 : layer == 1 ? 4 : layer == 2 ? 8 : 14;
    const int j1 = layer == 0 ? 4 : layer == 1 ? 8 : layer == 2 ? 14 : 18;
#pragma unroll 1
    for (int j = j0; j < j1; ++j) {
        const TJob jb = g_jobs[j];
        const float* W = inp(__builtin_amdgcn_readfirstlane(jb.in_idx)) + jb.src_off;
        bf16_t* dst = (bf16_t*)(p.ws + jb.dst_off);
        if (jb.N >= 256) {
            const int total = (jb.K >> 6) * (jb.N >> 8);
            for (int s = brel; s < total; s += nblk) transpose_strip(W, jb.K, jb.N, jb.map, dst, jb.dst_ld, s, tl);
        } else {
            const int total = (jb.K >> 6) * ((jb.N + 63) >> 6);
            for (int s = brel; s < total; s += nblk) transpose_item(W, jb.K, jb.N, jb.map, dst, jb.dst_ld, jb.row_off, s, tl);
        }
    }
    if (layer == 2) {
        u32x4* z = (u32x4*)(p.ws + WS_WGIN + 3104ull * 1024 * 2);
        const int n16 = 224 * 1024 * 2 / 16;
        for (int i = brel * NTHREADS + otid(); i < n16; i += nblk * NTHREADS) z[i] = (u32x4){0, 0, 0, 0};
    }
}

DEVI void phase_prep0(const Params& p, unsigned char* smem) {
    float* tl = (float*)smem;
    for (int it = obid(); it < N_MODJOBS; it += gridDim.x) mod_job(p, it, tl);
    const int G = gridDim.x;
    prep_layer(p, 0, (obid() + G - (N_MODJOBS % G)) % G, G, smem);
}

DEVI void phase_modfinal(const Params& p) {
    const float* P = (const float*)(p.ws + WS_MODP);
    float* Mo = (float*)(p.ws + WS_MOD);
    for (int idx = obid() * NTHREADS + otid(); idx < 4 * 3 * 6144; idx += gridDim.x * NTHREADS) {
        const int l = idx / 18432, rem = idx - l * 18432, c = rem / 6144, j = rem - c * 6144;
        float s = inp(9)[l * 6144 + j];
#pragma unroll 8
        for (int kc = 0; kc < N_MODPART; ++kc) s += P[(size_t)((kc * 4 + l) * 3 + c) * 6144 + j];
        Mo[idx] = s;
    }
}

template <int MODE>
DEVI void phase_rows(const Params& p, const float* lng, const float* lnb, const float* modn, int ch_sh, int ch_sc, bool write_out) {
    float* X = (float*)(p.ws + WS_X);
    bf16_t* H = (bf16_t*)(p.ws + WS_H);
    const int lane = otid() & 63;
    const int gw = obid() * 8 + (otid() >> 6), NW = gridDim.x * 8;
    for (int row = gw; row < MTOK; row += NW) {
        const float* src = (MODE == 0) ? (row < MP ? inp(0) + (size_t)row * D : inp(1) + (size_t)(row - MP) * D) : X + (size_t)row * D;
        f32x4 v[4];
#pragma unroll
        for (int j = 0; j < 4; ++j) v[j] = ((const f32x4*)src)[lane + 64 * j];
        if (MODE == 1) {
            float s = 0.f;
#pragma unroll
            for (int j = 0; j < 4; ++j) s += (v[j].x + v[j].y) + (v[j].z + v[j].w);
            const float mean = wave_sum(s) * (1.f / D);
            float s2 = 0.f;
#pragma unroll
            for (int j = 0; j < 4; ++j) { v[j] = v[j] - mean; s2 += (v[j].x * v[j].x + v[j].y * v[j].y) + (v[j].z * v[j].z + v[j].w * v[j].w); }
            const float rstd = rsqrtf(wave_sum(s2) * (1.f / D) + 1e-5f);
#pragma unroll
            for (int j = 0; j < 4; ++j) {
                const f32x4 g = ((const f32x4*)lng)[lane + 64 * j], b = ((const f32x4*)lnb)[lane + 64 * j];
                v[j] = v[j] * rstd * g + b;
            }
        }
#pragma unroll
        for (int j = 0; j < 4; ++j) ((f32x4*)(X + (size_t)row * D))[lane + 64 * j] = v[j];
        if (write_out) {
#pragma unroll
            for (int j = 0; j < 4; ++j) ((f32x4*)(p.out + OUT_Y + (size_t)row * D))[lane + 64 * j] = v[j];
        }
        if (modn) {
            const int cond = row_cond(row);
            const float* sc = modn + cond * 6144 + ch_sc * 1024;
            const float* sh = modn + cond * 6144 + ch_sh * 1024;
#pragma unroll
            for (int j = 0; j < 4; ++j) {
                const f32x4 a = ((const f32x4*)sc)[lane + 64 * j], b = ((const f32x4*)sh)[lane + 64 * j];
                const f32x4 h = v[j] * (a + 1.f) + b;
                u32x2 o; o.x = pk2(h.x, h.y); o.y = pk2(h.z, h.w);
                ((u32x2*)(H + (size_t)row * D))[lane + 64 * j] = o;
            }
        }
    }
}

namespace pg8 {
#define PG8_LAS __attribute__((address_space(3)))
constexpr int BM = 256, BK = 64, HALF = 128, HTB = HALF * BK * 2, STAGE_BYTES = 8 * HTB, NXCD = 8, WGM = 8;
DEVI int lds_byte(int r, int c) { const int st = (r >> 4) * 2 + (c >> 5), rr = r & 15, cc = c & 31, ob = rr * 64 + cc * 2; return st * 1024 + (ob ^ (((ob >> 9) & 1) << 5)); }
DEVI void stage_rc(int b, int& R, int& C) { const int st = b / 1024, sb = b % 1024, swz = sb ^ (((sb >> 9) & 1) << 5); R = (st >> 1) * 16 + swz / 64; C = (st & 1) * 32 + (swz % 64) / 2; }
DEVI int perm32(int rho) { const int n = rho >> 4, i = rho & 15; return 8 * (i >> 2) + 4 * n + (i & 3); }
struct Unit { int pm, pn; };
struct Gemm { const bf16_t* A; const bf16_t* Bt; int M, N, K; };
struct StaticOrder {
    int nM, nN, nwg, G, c;
    DEVI void init(int M, int N, int G_, int c_) { nM = M / BM; nN = N / BM; nwg = nM * nN; G = G_; c = c_; }
    DEVI bool next(int i, Unit& u) const {
        const long L = (long)i * G + c; if (L >= nwg) return false;
        int wgid = (int)L; { const int q = nwg / NXCD, r = nwg % NXCD, xcd = wgid % NXCD, off = wgid / NXCD; wgid = (xcd < r ? xcd * (q + 1) : r * (q + 1) + (xcd - r) * q) + off; }
        const int nig = WGM * nN, gid = wgid / nig, fm = gid * WGM, gsz = (nM - fm) < WGM ? (nM - fm) : WGM;
        u.pm = fm + ((wgid % nig) % gsz); u.pn = (wgid % nig) / gsz; return true;
    }
    DEVI void a_ready(const Unit&) const {}
    DEVI void done(const Unit&) const {}
};
struct EpiStore {
    static constexpr bool PERM = true, AFTER_DRAIN = false;
    bf16_t* O; int ldo;
    DEVI void operator()(const f32x4 (&acc)[2][2][4][2], const Unit& u, int wr, int wc, int fr, int fq) const {
        const int row0 = u.pm * BM + wr * 64 + fr, col0 = u.pn * BM + wc * 32 + 8 * fq;
#pragma unroll
        for (int ai = 0; ai < 2; ++ai)
#pragma unroll
            for (int m = 0; m < 4; ++m) { bf16_t* rowp = O + (size_t)(row0 + ai * HALF + m * 16) * ldo + col0;
#pragma unroll
                for (int bj = 0; bj < 2; ++bj) { const f32x4 v0 = acc[ai][bj][m][0], v1 = acc[ai][bj][m][1];
                    u32x4 w; w.x = pk2(v0[0], v0[1]); w.y = pk2(v0[2], v0[3]); w.z = pk2(v1[0], v1[1]); w.w = pk2(v1[2], v1[3]);
                    *(u32x4*)(rowp + bj * HALF) = w; } }
    }
};
struct EpiSwiglu {
    static constexpr bool PERM = true, AFTER_DRAIN = false;
    bf16_t* O; int ldo;
    DEVI void operator()(const f32x4 (&acc)[2][2][4][2], const Unit& u, int wr, int wc, int fr, int fq) const {
        const int row0 = u.pm * BM + wr * 64 + fr, col0 = u.pn * HALF + wc * 32 + 8 * fq;
#pragma unroll
        for (int ai = 0; ai < 2; ++ai)
#pragma unroll
            for (int m = 0; m < 4; ++m) { bf16_t* rowp = O + (size_t)(row0 + ai * HALF + m * 16) * ldo + col0;
                const f32x4 g0 = acc[ai][0][m][0], g1 = acc[ai][0][m][1], u0 = acc[ai][1][m][0], u1 = acc[ai][1][m][1];
                u32x4 w; w.x = pk2(silu_f(g0[0]) * u0[0], silu_f(g0[1]) * u0[1]); w.y = pk2(silu_f(g0[2]) * u0[2], silu_f(g0[3]) * u0[3]);
                w.z = pk2(silu_f(g1[0]) * u1[0], silu_f(g1[1]) * u1[1]); w.w = pk2(silu_f(g1[2]) * u1[2], silu_f(g1[3]) * u1[3]);
                *(u32x4*)rowp = w; }
    }
};
struct EpiResid {
    static constexpr bool PERM = true, AFTER_DRAIN = false;
    float* X; const float* ga;
    DEVI void operator()(const f32x4 (&acc)[2][2][4][2], const Unit& u, int wr, int wc, int fr, int fq) const {
        const int row0 = u.pm * BM + wr * 64 + fr, col0 = u.pn * BM + wc * 32 + 8 * fq;
        const int cond = u.pm < 16 ? 0 : 1 + ((u.pm - 16) >> 3);
        const float* g = ga + cond * 6144 + col0;
#pragma unroll
        for (int bj = 0; bj < 2; ++bj) {
            const f32x4 g0 = *(const f32x4*)(g + bj * HALF), g1 = *(const f32x4*)(g + bj * HALF + 4);
#pragma unroll
            for (int ai = 0; ai < 2; ++ai)
#pragma unroll
                for (int m = 0; m < 4; ++m) { float* xp = X + (size_t)(row0 + ai * HALF + m * 16) * D + col0 + bj * HALF;
                    const f32x4 x0 = *(const f32x4*)xp, x1 = *(const f32x4*)(xp + 4);
                    *(f32x4*)xp = x0 * ALPHA + g0 * acc[ai][bj][m][0]; *(f32x4*)(xp + 4) = x1 * ALPHA + g1 * acc[ai][bj][m][1]; }
        }
    }
};
template <class Epi, class Sched, bool ALIGN_EPI = false, bool SP2 = false>
__device__ __forceinline__ void gemm_phase(PG8_LAS unsigned char* lds, const Gemm g, const Sched& S, const Epi& E) {
    const int tid = otid(), wid = __builtin_amdgcn_readfirstlane(tid >> 6), lane = tid & 63, wr = wid >> 2, wc = wid & 3, fr = lane & 15, fq = lane >> 4;
    const int K = g.K, nt = K / BK;
    unsigned voffA[2], voffB[2];
#pragma unroll
    for (int i = 0; i < 2; ++i) { int R, C; stage_rc(tid * 16 + i * 8192, R, C); const int Rb = Epi::PERM ? ((R & ~31) + perm32(R & 31)) : R;
        voffA[i] = (unsigned)(R * K + C) * 2u; voffB[i] = (unsigned)(Rb * K + C) * 2u; }
    const size_t kstep = (size_t)(BK * 2);
    const size_t hstep = (size_t)HALF * K * 2;
    const size_t tstep = 2 * hstep;
    const unsigned ldsw = (unsigned)wid * 1024u;
    const int aoff = lds_byte(wr * 64 + fr, fq * 8), boff = lds_byte(wc * 32 + fr, fq * 8);
#define PG8_SA(b, h) (((b) * 2 + (h)) * HTB)
#define PG8_SB(b, h) ((4 + (b) * 2 + (h)) * HTB)
#define PG8_STAGE(bufoff, gbase, voff) do { _Pragma("unroll") for (int _i = 0; _i < 2; ++_i) \
        __builtin_amdgcn_global_load_lds((const unsigned*)((const char*)(gbase) + (voff)[_i]), (PG8_LAS unsigned*)(lds + (bufoff) + ldsw + _i * 8192), 16, 0, 0); } while (0)
#define PG8_LDA(dst, b, h) do { _Pragma("unroll") for (int m = 0; m < 4; ++m) _Pragma("unroll") for (int k = 0; k < 2; ++k) dst[m][k] = *(const PG8_LAS bf16x8*)(lds + PG8_SA(b, h) + aoff + m * 2048 + k * 1024); } while (0)
#define PG8_LDB(dst, b, h) do { _Pragma("unroll") for (int n = 0; n < 2; ++n) _Pragma("unroll") for (int k = 0; k < 2; ++k) dst[n][k] = *(const PG8_LAS bf16x8*)(lds + PG8_SB(b, h) + boff + n * 2048 + k * 1024); } while (0)
#define PG8_MMA(ai, bj, At, Bt) do { __builtin_amdgcn_s_setprio(1); _Pragma("unroll") for (int m = 0; m < 4; ++m) _Pragma("unroll") for (int n = 0; n < 2; ++n) _Pragma("unroll") for (int k = 0; k < 2; ++k) \
        acc[ai][bj][m][n] = __builtin_amdgcn_mfma_f32_16x16x32_bf16(Bt[n][k], At[m][k], acc[ai][bj][m][n], 0, 0, 0); __builtin_amdgcn_s_setprio(0); } while (0)
#define PG8_WAIT_V(n) asm volatile("s_waitcnt vmcnt(" #n ")" ::: "memory")
#define PG8_WAIT_L(n) asm volatile("s_waitcnt lgkmcnt(" #n ")" ::: "memory")
#define PG8_BAR __builtin_amdgcn_s_barrier()
#define PG8_SCHED __builtin_amdgcn_sched_barrier(0)
    Unit cur, nxt; int ui = 0;
    if (!S.next(0, cur)) return;
    f32x4 acc[2][2][4][2];
#pragma unroll
    for (int a = 0; a < 2; ++a)
#pragma unroll
        for (int b = 0; b < 2; ++b)
#pragma unroll
            for (int m = 0; m < 4; ++m)
#pragma unroll
                for (int n = 0; n < 2; ++n) acc[a][b][m][n] = (f32x4){0.f, 0.f, 0.f, 0.f};
    bf16x8 At[4][2], B0[2][2], B1[2][2];
    const char* cA = (const char*)g.A + (size_t)cur.pm * tstep; const char* cB = (const char*)g.Bt + (size_t)cur.pn * tstep;
    S.a_ready(cur);
    if constexpr (SP2) {
        PG8_STAGE(PG8_SB(0, 0), cB, voffB); PG8_STAGE(PG8_SB(0, 1), cB + hstep, voffB); PG8_STAGE(PG8_SA(0, 0), cA, voffA); PG8_STAGE(PG8_SA(0, 1), cA + hstep, voffA);
        if (wr == 1) PG8_BAR;
        PG8_WAIT_V(2); PG8_BAR;
        PG8_STAGE(PG8_SB(1, 0), cB + kstep, voffB); PG8_STAGE(PG8_SA(1, 0), cA + kstep, voffA); PG8_STAGE(PG8_SB(1, 1), cB + hstep + kstep, voffB);
        PG8_WAIT_V(6); PG8_BAR;
    } else {
        PG8_STAGE(PG8_SB(0, 0), cB, voffB); PG8_STAGE(PG8_SA(0, 0), cA, voffA); PG8_STAGE(PG8_SB(0, 1), cB + hstep, voffB); PG8_STAGE(PG8_SA(0, 1), cA + hstep, voffA);
        if (wr == 1) PG8_BAR;
        PG8_WAIT_V(4); PG8_BAR;
        PG8_STAGE(PG8_SB(1, 0), cB + kstep, voffB); PG8_STAGE(PG8_SA(1, 0), cA + kstep, voffA); PG8_STAGE(PG8_SB(1, 1), cB + hstep + kstep, voffB);
        PG8_WAIT_V(6); PG8_BAR;
    }
    for (;;) {
        const bool has_next = S.next(ui + 1, nxt);
        const char* nA = has_next ? (const char*)g.A + (size_t)nxt.pm * tstep : cA; const char* nB = has_next ? (const char*)g.Bt + (size_t)nxt.pn * tstep : cB;
        for (int t = 0; t < nt; t += 2) {
            const bool last = (t == nt - 2);
            const char* a1 = cA + (size_t)(t + 1) * kstep;
            const char* a2 = last ? nA : cA + (size_t)(t + 2) * kstep; const char* b2 = last ? nB : cB + (size_t)(t + 2) * kstep;
            const char* a3 = a2 + kstep; const char* b3 = b2 + kstep;
            if (last && has_next) S.a_ready(nxt);
            if constexpr (SP2) {
            PG8_LDB(B0, 0, 0); PG8_LDB(B1, 0, 1); PG8_SCHED; PG8_LDA(At, 0, 0); PG8_STAGE(PG8_SA(1, 1), a1 + hstep, voffA);
            PG8_WAIT_V(8); PG8_WAIT_L(0); PG8_BAR; PG8_MMA(0, 0, At, B0); PG8_MMA(0, 1, At, B1); PG8_BAR; PG8_SCHED;
            PG8_LDA(At, 0, 1); PG8_STAGE(PG8_SB(0, 0), b2, voffB); PG8_STAGE(PG8_SB(0, 1), b2 + hstep, voffB); PG8_STAGE(PG8_SA(0, 0), a2, voffA);
            PG8_WAIT_V(8); PG8_WAIT_L(0); PG8_BAR; PG8_MMA(1, 0, At, B0); PG8_MMA(1, 1, At, B1); PG8_BAR; PG8_SCHED;
            PG8_LDB(B0, 1, 0); PG8_LDB(B1, 1, 1); PG8_SCHED; PG8_LDA(At, 1, 0); PG8_STAGE(PG8_SA(0, 1), a2 + hstep, voffA);
            PG8_WAIT_V(8); PG8_WAIT_L(0); PG8_BAR; PG8_MMA(0, 0, At, B0); PG8_MMA(0, 1, At, B1); PG8_BAR; PG8_SCHED;
            PG8_LDA(At, 1, 1); PG8_STAGE(PG8_SB(1, 0), b3, voffB); PG8_STAGE(PG8_SB(1, 1), b3 + hstep, voffB); PG8_STAGE(PG8_SA(1, 0), a3, voffA);
            PG8_WAIT_V(8); PG8_WAIT_L(0); PG8_BAR; PG8_MMA(1, 0, At, B0); PG8_MMA(1, 1, At, B1); PG8_BAR; PG8_SCHED;
            } else {
            PG8_LDB(B0, 0, 0); PG8_SCHED; PG8_LDA(At, 0, 0); PG8_STAGE(PG8_SA(1, 1), a1 + hstep, voffA);
            PG8_WAIT_L(8); PG8_BAR; PG8_WAIT_L(0); PG8_MMA(0, 0, At, B0); PG8_BAR; PG8_SCHED;
            PG8_LDB(B1, 0, 1); PG8_STAGE(PG8_SB(0, 0), b2, voffB);
            PG8_BAR; PG8_WAIT_L(0); PG8_MMA(0, 1, At, B1); PG8_BAR;
            PG8_LDA(At, 0, 1); PG8_STAGE(PG8_SA(0, 0), a2, voffA);
            PG8_BAR; PG8_WAIT_L(0); PG8_MMA(1, 0, At, B0); PG8_BAR; PG8_SCHED;
            PG8_STAGE(PG8_SB(0, 1), b2 + hstep, voffB);
            PG8_WAIT_V(6); PG8_BAR; PG8_MMA(1, 1, At, B1); PG8_BAR;
            PG8_LDB(B0, 1, 0); PG8_SCHED; PG8_LDA(At, 1, 0); PG8_STAGE(PG8_SA(0, 1), a2 + hstep, voffA);
            PG8_WAIT_L(8); PG8_BAR; PG8_WAIT_L(0); PG8_MMA(0, 0, At, B0); PG8_BAR; PG8_SCHED;
            PG8_LDB(B1, 1, 1); PG8_STAGE(PG8_SB(1, 0), b3, voffB);
            PG8_BAR; PG8_WAIT_L(0); PG8_MMA(0, 1, At, B1); PG8_BAR;
            PG8_LDA(At, 1, 1); PG8_STAGE(PG8_SA(1, 0), a3, voffA);
            PG8_BAR; PG8_WAIT_L(0); PG8_MMA(1, 0, At, B0); PG8_BAR; PG8_SCHED;
            PG8_STAGE(PG8_SB(1, 1), b3 + hstep, voffB);
            PG8_WAIT_V(6); PG8_BAR; PG8_MMA(1, 1, At, B1); PG8_BAR;
            }
        }
        if constexpr (ALIGN_EPI) { if (wr == 0) PG8_BAR; }
        if constexpr (!Epi::AFTER_DRAIN) { E(acc, cur, wr, wc, fr, fq); S.done(cur); }
        if (!has_next) break;
#pragma unroll
        for (int a = 0; a < 2; ++a)
#pragma unroll
            for (int b = 0; b < 2; ++b)
#pragma unroll
                for (int m = 0; m < 4; ++m)
#pragma unroll
                    for (int n = 0; n < 2; ++n) acc[a][b][m][n] = (f32x4){0.f, 0.f, 0.f, 0.f};
        cur = nxt; cA = nA; cB = nB; ++ui;
        if constexpr (ALIGN_EPI) { if (wr == 1) PG8_BAR; }
    }
    PG8_WAIT_V(0);
    if constexpr (!ALIGN_EPI) { if (wr == 0) PG8_BAR; }
    PG8_BAR;
    if constexpr (Epi::AFTER_DRAIN) { E.fused(acc, cur, wr, wc, fr, fq, lds, wid, lane); S.done(cur); }
#undef PG8_SA
#undef PG8_SB
#undef PG8_STAGE
#undef PG8_LDA
#undef PG8_LDB
#undef PG8_MMA
#undef PG8_WAIT_V
#undef PG8_WAIT_L
#undef PG8_BAR
#undef PG8_SCHED
}
}

DEVI void phase_conv(const Params& p, int j) {
    const bf16_t* U = (const bf16_t*)(p.ws + WS_BIG);
    bf16_t* Z = (bf16_t*)(p.ws + WS_Z);
    const float* cw = inp(13) + (size_t)j * 3 * D;
    for (int it = obid() * NTHREADS + otid(); it < MTOK * 128; it += gridDim.x * NTHREADS) {
        const int row = it >> 7, c8 = (it & 127) * 8;
        int s, Ls; if (row < MP) { s = row & 255; Ls = 256; } else { s = (row - MP) & 2047; Ls = 2048; }
        const bf16_t* ur = U + (size_t)row * 3072;
        const u32x4 bg = *(const u32x4*)(ur + c8);
        const u32x4 c0 = *(const u32x4*)(ur + 1024 + c8), u0 = *(const u32x4*)(ur + 2048 + c8);
        u32x4 cp = {0, 0, 0, 0}, up = cp, cn = cp, un = cp;
        if (s > 0) { cp = *(const u32x4*)(ur - 3072 + 1024 + c8); up = *(const u32x4*)(ur - 3072 + 2048 + c8); }
        if (s < Ls - 1) { cn = *(const u32x4*)(ur + 3072 + 1024 + c8); un = *(const u32x4*)(ur + 3072 + 2048 + c8); }
        float w0[8], w1[8], w2[8];
#pragma unroll
        for (int i = 0; i < 2; ++i) {
            const f32x4 a = *(const f32x4*)(cw + c8 + 4 * i), b = *(const f32x4*)(cw + D + c8 + 4 * i), c = *(const f32x4*)(cw + 2 * D + c8 + 4 * i);
#pragma unroll
            for (int q = 0; q < 4; ++q) { w0[4 * i + q] = a[q]; w1[4 * i + q] = b[q]; w2[4 * i + q] = c[q]; }
        }
        u32x4 o;
#pragma unroll
        for (int q = 0; q < 4; ++q) {
            const float vlo = bflo(bg[q]) * (w0[2 * q] * bflo(cp[q]) * bflo(up[q]) + w1[2 * q] * bflo(c0[q]) * bflo(u0[q]) + w2[2 * q] * bflo(cn[q]) * bflo(un[q]));
            const float vhi = bfhi(bg[q]) * (w0[2 * q + 1] * bfhi(cp[q]) * bfhi(up[q]) + w1[2 * q + 1] * bfhi(c0[q]) * bfhi(u0[q]) + w2[2 * q + 1] * bfhi(cn[q]) * bfhi(un[q]));
            o[q] = pk2(vlo, vhi);
        }
        *(u32x4*)(Z + (size_t)row * D + c8) = o;
    }
}

DEVI void phase_attn_prep(const Params& p, unsigned char* smem) {
    const bf16_t* QKV = (const bf16_t*)(p.ws + WS_BIG);
    bf16_t* Qb = (bf16_t*)(p.ws + WS_AQ);
    bf16_t* KP = (bf16_t*)(p.ws + WS_AKP);
    bf16_t* KS = (bf16_t*)(p.ws + WS_AKS);
    bf16_t* VP = (bf16_t*)(p.ws + WS_AVP);
    bf16_t* VS = (bf16_t*)(p.ws + WS_AVS);
    const float* qg = inp(16); const float* kg = inp(17);
    const int lane = otid() & 63;
    const int gw = obid() * 8 + (otid() >> 6), NW = gridDim.x * 8;
    {
        const int sub = lane >> 4, jl = lane & 15;
        const int ax = jl >> 3, half = (jl & 7) >> 2, f0 = (jl & 3) * 8;
        for (int base = gw * 4; base < MTOK * 10; base += NW * 4) {
            const int it = base + sub;
            const int row = it / 10, slot = it - row * 10;
            const u32x4 raw = *(const u32x4*)(QKV + (size_t)row * 1536 + slot * 128 + jl * 8);
            float x[8];
#pragma unroll
            for (int q = 0; q < 4; ++q) { x[2 * q] = bflo(raw[q]); x[2 * q + 1] = bfhi(raw[q]); }
            float ss = 0.f;
#pragma unroll
            for (int q = 0; q < 8; ++q) ss += x[q] * x[q];
            ss += __shfl_xor(ss, 1); ss += __shfl_xor(ss, 2); ss += __shfl_xor(ss, 4); ss += __shfl_xor(ss, 8);
            const float rstd = rsqrtf(ss * (1.f / 128.f) + 1e-6f);
            const float* g = (slot < 8 ? qg : kg) + jl * 8;
            const f32x4 g0 = *(const f32x4*)g, g1 = *(const f32x4*)(g + 4);
            x[0] *= rstd * g0.x; x[1] *= rstd * g0.y; x[2] *= rstd * g0.z; x[3] *= rstd * g0.w;
            x[4] *= rstd * g1.x; x[5] *= rstd * g1.y; x[6] *= rstd * g1.z; x[7] *= rstd * g1.w;
            if (row >= MP) {
                const int s = (row - MP) & 2047;
                const float pos = ax == 0 ? (float)(s >> 6) : (float)(s & 63);
#pragma unroll
                for (int q = 0; q < 8; ++q) {
                    const float other = __shfl_xor(x[q], 4);
                    const float fr_ = exp2f(-(float)(f0 + q) * (13.287712379549449f / 32.f));
                    float sn, cs; sincosf(pos * fr_, &sn, &cs);
                    x[q] = half == 0 ? (x[q] * cs - other * sn) : (x[q] * cs + other * sn);
                }
            }
            if (slot < 8) {
                const float sc = 0.08838834764831845f * 1.4426950408889634f;
                u32x4 o; o.x = pk2(x[0] * sc, x[1] * sc); o.y = pk2(x[2] * sc, x[3] * sc); o.z = pk2(x[4] * sc, x[5] * sc); o.w = pk2(x[6] * sc, x[7] * sc);
                *(u32x4*)(Qb + (size_t)row * D + slot * 128 + jl * 8) = o;
            } else {
                const int kvh = slot - 8;
                u32x4 o; o.x = pk2(x[0], x[1]); o.y = pk2(x[2], x[3]); o.z = pk2(x[4], x[5]); o.w = pk2(x[6], x[7]);
                if (row < MP) {
                    *(u32x4*)(KP + (size_t)row * 256 + kvh * 128 + jl * 8) = o;
                    float* oc = p.out + OUT_CK + (size_t)row * 256 + kvh * 128 + jl * 8;
                    *(f32x4*)oc = (f32x4){x[0], x[1], x[2], x[3]}; *(f32x4*)(oc + 4) = (f32x4){x[4], x[5], x[6], x[7]};
                } else {
                    const int b = (row - MP) >> 11, s = (row - MP) & 2047;
                    *(u32x4*)(KS + ((size_t)b * 2304 + 256 + s) * 256 + kvh * 128 + jl * 8) = o;
                }
            }
        }
    }
    for (int it = obid() * NTHREADS + otid(); it < 2 * 256 * 256 / 4; it += gridDim.x * NTHREADS) {
        const int e = it * 4, b = e >> 16, r = e & 65535;
        const f32x4 v = *(const f32x4*)(inp(3) + e);
        u32x2 o; o.x = pk2(v.x, v.y); o.y = pk2(v.z, v.w);
        *(u32x2*)(KS + (size_t)b * 2304 * 256 + r) = o;
    }
    bf16_t* vl = (bf16_t*)smem;
    for (int job = obid(); job < 64 + 72; job += gridDim.x) {
        int nkeys, kb; bf16_t* dst; const bf16_t* srcb = nullptr; const float* srcf = nullptr; float* outv = nullptr;
        if (job < 64) { const int b = job >> 2; kb = job & 3; nkeys = 256; dst = VP + (size_t)b * 2 * 128 * 256;
            srcb = QKV + (size_t)(b * 256 + kb * 64) * 1536 + 1280; outv = p.out + OUT_CV + (size_t)(b * 256 + kb * 64) * 256; }
        else { const int jj = job - 64, b = jj / 36; kb = jj - b * 36; nkeys = 2304; dst = VS + (size_t)b * 2 * 128 * 2304;
            if (kb < 4) srcf = inp(4) + (size_t)b * 65536 + (size_t)kb * 64 * 256;
            else srcb = QKV + (size_t)(MP + b * 2048 + (kb - 4) * 64) * 1536 + 1280; }
        for (int c = otid(); c < 64 * 32; c += NTHREADS) {
            const int key = c >> 5, c8 = (c & 31) * 8;
            u32x4 v;
            if (srcb) v = *(const u32x4*)(srcb + (size_t)key * 1536 + c8);
            else { const f32x4 a = *(const f32x4*)(srcf + key * 256 + c8), b2 = *(const f32x4*)(srcf + key * 256 + c8 + 4);
                v.x = pk2(a.x, a.y); v.y = pk2(a.z, a.w); v.z = pk2(b2.x, b2.y); v.w = pk2(b2.z, b2.w); }
            *(u32x4*)(vl + key * 264 + c8) = v;
            if (outv) {
                f32x4 a = {bflo(v.x), bfhi(v.x), bflo(v.y), bfhi(v.y)}, b2 = {bflo(v.z), bfhi(v.z), bflo(v.w), bfhi(v.w)};
                *(f32x4*)(outv + key * 256 + c8) = a; *(f32x4*)(outv + key * 256 + c8 + 4) = b2;
            }
        }
        __syncthreads();
        {
            const int rowv = otid() >> 1, half = otid() & 1;
            bf16_t* drow = dst + (size_t)rowv * nkeys + kb * 64 + half * 32;
#pragma unroll
            for (int q = 0; q < 4; ++q) {
                unsigned w[4];
#pragma unroll
                for (int e = 0; e < 4; ++e) {
                    const int k0 = half * 32 + q * 8 + e * 2;
                    w[e] = (unsigned)vl[k0 * 264 + rowv] | ((unsigned)vl[(k0 + 1) * 264 + rowv] << 16);
                }
                *(u32x4*)(drow + q * 8) = (u32x4){w[0], w[1], w[2], w[3]};
            }
        }
        __syncthreads();
    }
}

constexpr int KSTR = 272, VSTR = 144;
constexpr int ATT_KB = 64 * KSTR, ATT_VB = 128 * VSTR, ATT_BUF = ATT_KB + ATT_VB;
DEVI void phase_attn(const Params& p, unsigned char* smem) {
    const bf16_t* Qb = (const bf16_t*)(p.ws + WS_AQ);
    bf16_t* Z = (bf16_t*)(p.ws + WS_Z);
    const int tid = otid(), wave = tid >> 6, lane = tid & 63, fr = lane & 15, fq = lane >> 4;
    for (int u = obid(); u < 512; u += gridDim.x) {
        int h, nkeys, rowbase; const bf16_t* Kbase; const bf16_t* Vbase;
        if (u < 256) { const int b = u >> 7, qb = u & 15; h = (u >> 4) & 7; nkeys = 2304; rowbase = MP + b * 2048 + qb * 128;
            Kbase = (const bf16_t*)(p.ws + WS_AKS) + (size_t)b * 2304 * 256 + (h >> 2) * 128;
            Vbase = (const bf16_t*)(p.ws + WS_AVS) + (size_t)(b * 2 + (h >> 2)) * 128 * 2304; }
        else { const int v = u - 256, b = v >> 4, qb = v & 1; h = (v >> 1) & 7; nkeys = 256; rowbase = b * 256 + qb * 128;
            Kbase = (const bf16_t*)(p.ws + WS_AKP) + (size_t)b * 256 * 256 + (h >> 2) * 128;
            Vbase = (const bf16_t*)(p.ws + WS_AVP) + (size_t)(b * 2 + (h >> 2)) * 128 * 256; }
        const int ntiles = nkeys >> 6;
        bf16x8 qf[4];
        { const bf16_t* qp = Qb + (size_t)(rowbase + wave * 16 + fr) * D + h * 128 + fq * 8;
#pragma unroll
          for (int ks = 0; ks < 4; ++ks) qf[ks] = *(const bf16x8*)(qp + ks * 32); }
        f32x4 o[8];
#pragma unroll
        for (int dt = 0; dt < 8; ++dt) o[dt] = (f32x4){0, 0, 0, 0};
        float mrun = -1e30f, lsum = 0.f;
        const int kr0 = tid >> 4, kc0 = tid & 15;
        const int vr0 = tid >> 3, vc0 = tid & 7;
        u32x4 kreg[2], vreg[2];
#define ATT_LOAD(t) do { \
        kreg[0] = *(const u32x4*)(Kbase + (size_t)((t) * 64 + kr0) * 256 + kc0 * 8); \
        kreg[1] = *(const u32x4*)(Kbase + (size_t)((t) * 64 + kr0 + 32) * 256 + kc0 * 8); \
        vreg[0] = *(const u32x4*)(Vbase + (size_t)vr0 * nkeys + (t) * 64 + vc0 * 8); \
        vreg[1] = *(const u32x4*)(Vbase + (size_t)(vr0 + 64) * nkeys + (t) * 64 + vc0 * 8); } while (0)
#define ATT_STORE(buf) do { unsigned char* kb_ = smem + (buf) * ATT_BUF; unsigned char* vb_ = kb_ + ATT_KB; \
        *(u32x4*)(kb_ + kr0 * KSTR + kc0 * 16) = kreg[0]; *(u32x4*)(kb_ + (kr0 + 32) * KSTR + kc0 * 16) = kreg[1]; \
        *(u32x4*)(vb_ + vr0 * VSTR + vc0 * 16) = vreg[0]; *(u32x4*)(vb_ + (vr0 + 64) * VSTR + vc0 * 16) = vreg[1]; } while (0)
        ATT_LOAD(0); ATT_STORE(0);
        __syncthreads();
        for (int t = 0; t < ntiles; ++t) {
            if (t + 1 < ntiles) ATT_LOAD(t + 1);
            const unsigned char* kb = smem + (t & 1) * ATT_BUF; const unsigned char* vb = kb + ATT_KB;
            f32x4 s[4];
#pragma unroll
            for (int kt = 0; kt < 4; ++kt) {
                s[kt] = (f32x4){0, 0, 0, 0};
#pragma unroll
                for (int ks = 0; ks < 4; ++ks) {
                    const bf16x8 kf = *(const bf16x8*)(kb + (kt * 16 + fr) * KSTR + (ks * 32 + fq * 8) * 2);
                    s[kt] = __builtin_amdgcn_mfma_f32_16x16x32_bf16(kf, qf[ks], s[kt], 0, 0, 0);
                }
            }
            float mx = -1e30f;
#pragma unroll
            for (int kt = 0; kt < 4; ++kt) mx = fmaxf(mx, fmaxf(fmaxf(s[kt].x, s[kt].y), fmaxf(s[kt].z, s[kt].w)));
            mx = fmaxf(mx, __shfl_xor(mx, 16)); mx = fmaxf(mx, __shfl_xor(mx, 32));
            const float mnew = fmaxf(mrun, mx);
            const float alpha = exp2f(mrun - mnew);
            mrun = mnew;
            float ps = 0.f;
#pragma unroll
            for (int kt = 0; kt < 4; ++kt) {
                s[kt].x = exp2f(s[kt].x - mnew); s[kt].y = exp2f(s[kt].y - mnew); s[kt].z = exp2f(s[kt].z - mnew); s[kt].w = exp2f(s[kt].w - mnew);
                ps += (s[kt].x + s[kt].y) + (s[kt].z + s[kt].w);
            }
            lsum = lsum * alpha + ps;
#pragma unroll
            for (int dt = 0; dt < 8; ++dt) o[dt] = o[dt] * alpha;
#pragma unroll
            for (int k2 = 0; k2 < 2; ++k2) {
                u32x4 pw; pw.x = pk2(s[2 * k2].x, s[2 * k2].y); pw.y = pk2(s[2 * k2].z, s[2 * k2].w);
                pw.z = pk2(s[2 * k2 + 1].x, s[2 * k2 + 1].y); pw.w = pk2(s[2 * k2 + 1].z, s[2 * k2 + 1].w);
                const bf16x8 pf = __builtin_bit_cast(bf16x8, pw);
#pragma unroll
                for (int dt = 0; dt < 8; ++dt) {
                    const unsigned char* vp = vb + (dt * 16 + fr) * VSTR + (k2 * 32 + fq * 4) * 2;
                    const u32x2 va = *(const u32x2*)vp, vc = *(const u32x2*)(vp + 32);
                    const u32x4 vw = {va.x, va.y, vc.x, vc.y};
                    o[dt] = __builtin_amdgcn_mfma_f32_16x16x32_bf16(__builtin_bit_cast(bf16x8, vw), pf, o[dt], 0, 0, 0);
                }
            }
            if (t + 1 < ntiles) ATT_STORE((t + 1) & 1);
            __syncthreads();
        }
        lsum += __shfl_xor(lsum, 16); lsum += __shfl_xor(lsum, 32);
        const float inv = 1.f / lsum;
        bf16_t* zp = Z + (size_t)(rowbase + wave * 16 + fr) * D + h * 128 + fq * 4;
#pragma unroll
        for (int dt = 0; dt < 8; ++dt) {
            u32x2 w; w.x = pk2(o[dt].x * inv, o[dt].y * inv); w.y = pk2(o[dt].z * inv, o[dt].w * inv);
            *(u32x2*)(zp + dt * 16) = w;
        }
#undef ATT_LOAD
#undef ATT_STORE
    }
}

constexpr int GLD = 3328;
constexpr int G_R1 = 65536;
constexpr int QK_STR = 136;
constexpr int T_STR = 72;
DEVI void phase_gla_a(const Params& p, unsigned char* smem) {
    const bf16_t* BIGb = (const bf16_t*)(p.ws + WS_BIG);
    bf16_t* GQ = (bf16_t*)(p.ws + WS_GQ);
    bf16_t* GA = (bf16_t*)(p.ws + WS_GA);
    float* GG = (float*)(p.ws + WS_GG);
    bf16_t* GU = (bf16_t*)(p.ws + WS_GU);
    bf16_t* GVT = (bf16_t*)(p.ws + WS_GVT);
    float* bc = (float*)smem;
    unsigned char* r1 = smem + G_R1;
    const int tid = otid(), wave = tid >> 6, lane = tid & 63, fr = lane & 15, fq = lane >> 4;
    for (int unit = obid(); unit < 512; unit += gridDim.x) {
        const int c = unit >> 2, h = unit & 3, r0 = c * 64;
        float* rl = (float*)r1;
        float* w2l = rl + 64 * 33;
        float* bl = w2l + 2 * 16 * 128;
        for (int i = tid; i < 64 * 32; i += NTHREADS) { const int t = i >> 5, q = i & 31; rl[t * 33 + q] = bf2f(BIGb[(size_t)(r0 + t) * GLD + 3072 + q]); }
        for (int i = tid; i < 2 * 16 * 128; i += NTHREADS) { const int dir = i >> 11, rk = (i >> 7) & 15, d = i & 127; w2l[i] = inp(21)[(size_t)(dir * 16 + rk) * 512 + h * 128 + d]; }
        if (tid < 256) { const int dir = tid >> 7, d = tid & 127; bl[tid] = inp(22)[dir * 512 + h * 128 + d]; }
        __syncthreads();
        for (int i = tid; i < 2 * 64 * 128; i += NTHREADS) {
            const int dir = i >> 13, t = (i >> 7) & 63, d = i & 127;
            float z = bl[dir * 128 + d];
#pragma unroll
            for (int q = 0; q < 16; ++q) z += rl[t * 33 + dir * 16 + q] * w2l[(dir * 16 + q) * 128 + d];
            const float ls = fminf(z, 0.f) - log1pf(__expf(-fabsf(z)));
            bc[i] = ls * (1.f / 16.f);
        }
        __syncthreads();
        if (tid < 256) {
            const int dir = tid >> 7, d = tid & 127;
            float run = 0.f;
            if (dir == 0) { for (int t = 0; t < 64; ++t) { run += bc[t * 128 + d]; bc[t * 128 + d] = run; } }
            else { for (int t = 63; t >= 0; --t) { run += bc[8192 + t * 128 + d]; bc[8192 + t * 128 + d] = run; } }
        }
        __syncthreads();
        bf16_t* qk = (bf16_t*)r1;
        for (int i = tid; i < 64 * 16; i += NTHREADS) {
            const int t = i >> 4, d8 = (i & 15) * 8;
            const u32x4 qv = *(const u32x4*)(BIGb + (size_t)(r0 + t) * GLD + h * 128 + d8);
            const u32x4 kv = *(const u32x4*)(BIGb + (size_t)(r0 + t) * GLD + 512 + h * 128 + d8);
            u32x4 oqf, oqb, okf, okb;
#pragma unroll
            for (int q = 0; q < 4; ++q) {
                const float bf0 = bc[t * 128 + d8 + 2 * q], bf1 = bc[t * 128 + d8 + 2 * q + 1];
                const float bb0 = bc[8192 + t * 128 + d8 + 2 * q], bb1 = bc[8192 + t * 128 + d8 + 2 * q + 1];
                const float q0 = bflo(qv[q]) * 0.08838834764831845f, q1 = bfhi(qv[q]) * 0.08838834764831845f;
                const float k0 = bflo(kv[q]), k1 = bfhi(kv[q]);
                oqf[q] = pk2(q0 * __expf(bf0), q1 * __expf(bf1));
                oqb[q] = pk2(q0 * __expf(bb0), q1 * __expf(bb1));
                okf[q] = pk2(k0 * __expf(-bf0), k1 * __expf(-bf1));
                okb[q] = pk2(k0 * __expf(-bb0), k1 * __expf(-bb1));
            }
            *(u32x4*)(qk + (0 * 64 + t) * QK_STR + d8) = oqf;
            *(u32x4*)(qk + (1 * 64 + t) * QK_STR + d8) = oqb;
            *(u32x4*)(qk + (2 * 64 + t) * QK_STR + d8) = okf;
            *(u32x4*)(qk + (3 * 64 + t) * QK_STR + d8) = okb;
            *(u32x4*)(GQ + (size_t)(r0 + t) * 512 + h * 128 + d8) = oqf;
            *(u32x4*)(GQ + (size_t)(MTOK + r0 + t) * 512 + h * 128 + d8) = oqb;
        }
        if (tid < 256) { const int dir = tid >> 7, d = tid & 127;
            GG[(size_t)(unit * 2 + dir) * 128 + d] = __expf(dir == 0 ? bc[63 * 128 + d] : bc[8192 + d]); }
        __syncthreads();
        {
            const int tr = wave & 3;
#pragma unroll
            for (int cc = 0; cc < 2; ++cc) {
                const int tc = (wave >> 2) * 2 + cc;
                f32x4 af = {0, 0, 0, 0}, ab = {0, 0, 0, 0};
#pragma unroll
                for (int ks = 0; ks < 4; ++ks) {
                    const bf16x8 qf_ = *(const bf16x8*)(qk + (0 * 64 + tr * 16 + fr) * QK_STR + ks * 32 + fq * 8);
                    const bf16x8 qb_ = *(const bf16x8*)(qk + (1 * 64 + tr * 16 + fr) * QK_STR + ks * 32 + fq * 8);
                    const bf16x8 kf_ = *(const bf16x8*)(qk + (2 * 64 + tc * 16 + fr) * QK_STR + ks * 32 + fq * 8);
                    const bf16x8 kb_ = *(const bf16x8*)(qk + (3 * 64 + tc * 16 + fr) * QK_STR + ks * 32 + fq * 8);
                    af = __builtin_amdgcn_mfma_f32_16x16x32_bf16(kf_, qf_, af, 0, 0, 0);
                    ab = __builtin_amdgcn_mfma_f32_16x16x32_bf16(kb_, qb_, ab, 0, 0, 0);
                }
                const int t = tr * 16 + fr, s0 = tc * 16 + fq * 4;
                float a[4];
#pragma unroll
                for (int j = 0; j < 4; ++j) { const int s = s0 + j; a[j] = (t >= s ? af[j] : 0.f) + (s >= t ? ab[j] : 0.f); }
                u32x2 w; w.x = pk2(a[0], a[1]); w.y = pk2(a[2], a[3]);
                *(u32x2*)(GA + ((size_t)unit * 64 + t) * 64 + s0) = w;
            }
        }
        __syncthreads();
        bf16_t* khT = (bf16_t*)r1;
        bf16_t* vT = khT + 2 * 128 * T_STR;
        for (int i = tid; i < 64 * 16; i += NTHREADS) {
            const int s = i & 63, d8 = (i >> 6) * 8;
            const u32x4 kv = *(const u32x4*)(BIGb + (size_t)(r0 + s) * GLD + 512 + h * 128 + d8);
#pragma unroll
            for (int q = 0; q < 8; ++q) {
                const int d = d8 + q;
                const float k = (q & 1) ? bfhi(kv[q >> 1]) : bflo(kv[q >> 1]);
                const float ef = __expf(bc[63 * 128 + d] - bc[s * 128 + d]);
                const float eb = __expf(bc[8192 + d] - bc[8192 + s * 128 + d]);
                khT[(0 * 128 + d) * T_STR + s] = (bf16_t)(pk2(k * ef, 0.f) & 0xffff);
                khT[(1 * 128 + d) * T_STR + s] = (bf16_t)(pk2(k * eb, 0.f) & 0xffff);
            }
        }
        for (int i = tid; i < 64 * 32; i += NTHREADS) {
            const int s = i & 63, e8 = (i >> 6) * 8;
            const u32x4 vv = *(const u32x4*)(BIGb + (size_t)(r0 + s) * GLD + 1024 + h * 256 + e8);
#pragma unroll
            for (int q = 0; q < 4; ++q) { vT[(e8 + 2 * q) * T_STR + s] = (bf16_t)(vv[q] & 0xffff); vT[(e8 + 2 * q + 1) * T_STR + s] = (bf16_t)(vv[q] >> 16); }
        }
        __syncthreads();
        for (int i = tid; i < 256 * 8; i += NTHREADS) {
            const int e = i >> 3, cch = i & 7;
            *(u32x4*)(GVT + ((size_t)unit * 256 + e) * 64 + cch * 8) = *(const u32x4*)(vT + e * T_STR + cch * 8);
        }
        {
            const int dir = wave >> 2;
            bf16_t* Uo = GU + (size_t)(unit * 2 + dir) * 256 * 128;
#pragma unroll 1
            for (int eh = 0; eh < 2; ++eh) {
                f32x4 acc[2][8];
#pragma unroll
                for (int a = 0; a < 2; ++a)
#pragma unroll
                    for (int b = 0; b < 8; ++b) acc[a][b] = (f32x4){0, 0, 0, 0};
#pragma unroll
                for (int ks = 0; ks < 2; ++ks) {
                    bf16x8 af[2];
#pragma unroll
                    for (int a = 0; a < 2; ++a) af[a] = *(const bf16x8*)(khT + (dir * 128 + ((wave & 3) * 2 + a) * 16 + fr) * T_STR + ks * 32 + fq * 8);
#pragma unroll
                    for (int b = 0; b < 8; ++b) {
                        const bf16x8 bfv = *(const bf16x8*)(vT + ((eh * 8 + b) * 16 + fr) * T_STR + ks * 32 + fq * 8);
#pragma unroll
                        for (int a = 0; a < 2; ++a) acc[a][b] = __builtin_amdgcn_mfma_f32_16x16x32_bf16(af[a], bfv, acc[a][b], 0, 0, 0);
                    }
                }
#pragma unroll
                for (int a = 0; a < 2; ++a)
#pragma unroll
                    for (int b = 0; b < 8; ++b) {
                        const int d0 = ((wave & 3) * 2 + a) * 16 + fq * 4, e = (eh * 8 + b) * 16 + fr;
                        u32x2 w; w.x = pk2(acc[a][b].x, acc[a][b].y); w.y = pk2(acc[a][b].z, acc[a][b].w);
                        *(u32x2*)(Uo + (size_t)e * 128 + d0) = w;
                    }
            }
        }
        __syncthreads();
    }
}

DEVI void phase_gla_scan(const Params& p) {
    bf16_t* GU = (bf16_t*)(p.ws + WS_GU);
    const float* GG = (const float*)(p.ws + WS_GG);
    const int T = gridDim.x * NTHREADS;
    for (int id = obid() * NTHREADS + otid(); id < 65536 + 524288; id += T) {
        int b, h, dir, e, d8, nc, c0; bool sample = id < 65536;
        int v = sample ? id : id - 65536;
        d8 = (v & 15) * 8; e = (v >> 4) & 255; dir = (v >> 12) & 1; h = (v >> 13) & 3; b = v >> 15;
        if (sample) { nc = 32; c0 = 64 + b * 32; } else { nc = 4; c0 = b * 4; }
        float run[8];
        if (sample) {
            const float* s0f = inp(5); const float* s0b = inp(6);
            const float* s0 = (dir == 0 ? s0f : s0b) + (size_t)(b * 4 + h) * 32768 + e;
#pragma unroll
            for (int q = 0; q < 8; ++q) run[q] = s0[(size_t)(d8 + q) * 256];
        } else {
#pragma unroll
            for (int q = 0; q < 8; ++q) run[q] = 0.f;
        }
        for (int i0 = 0; i0 < nc; i0 += 4) {
            bf16_t* up[4]; u32x4 uv[4]; f32x4 g0[4], g1[4];
#pragma unroll
            for (int k = 0; k < 4; ++k) {
                const int i = i0 + k, cs = dir == 0 ? i : nc - 1 - i;
                const int unit = (c0 + cs) * 4 + h;
                up[k] = GU + ((size_t)(unit * 2 + dir) * 256 + e) * 128 + d8;
                const float* gp = GG + (size_t)(unit * 2 + dir) * 128 + d8;
                uv[k] = *(const u32x4*)up[k];
                g0[k] = *(const f32x4*)gp; g1[k] = *(const f32x4*)(gp + 4);
            }
#pragma unroll
            for (int k = 0; k < 4; ++k) {
                u32x4 sv; sv.x = pk2(run[0], run[1]); sv.y = pk2(run[2], run[3]); sv.z = pk2(run[4], run[5]); sv.w = pk2(run[6], run[7]);
                *(u32x4*)up[k] = sv;
                run[0] = g0[k].x * run[0] + bflo(uv[k].x); run[1] = g0[k].y * run[1] + bfhi(uv[k].x);
                run[2] = g0[k].z * run[2] + bflo(uv[k].y); run[3] = g0[k].w * run[3] + bfhi(uv[k].y);
                run[4] = g1[k].x * run[4] + bflo(uv[k].z); run[5] = g1[k].y * run[5] + bfhi(uv[k].z);
                run[6] = g1[k].z * run[6] + bflo(uv[k].w); run[7] = g1[k].w * run[7] + bfhi(uv[k].w);
            }
        }
        if (!sample) {
            float* o = p.out + (dir == 0 ? OUT_SF : OUT_SB) + (size_t)(b * 4 + h) * 32768 + e;
#pragma unroll
            for (int q = 0; q < 8; ++q) o[(size_t)(d8 + q) * 256] = run[q];
        }
    }
}

constexpr int AOP_STR = 328;
DEVI void phase_gla_c(const Params& p, unsigned char* smem) {
    const bf16_t* BIGb = (const bf16_t*)(p.ws + WS_BIG);
    const bf16_t* GQ = (const bf16_t*)(p.ws + WS_GQ);
    const bf16_t* GA = (const bf16_t*)(p.ws + WS_GA);
    const bf16_t* GU = (const bf16_t*)(p.ws + WS_GU);
    const bf16_t* GVT = (const bf16_t*)(p.ws + WS_GVT);
    bf16_t* Z = (bf16_t*)(p.ws + WS_Z);
    const float* ng = inp(23);
    bf16_t* aop = (bf16_t*)smem;
    float* red = (float*)(smem + 64 * AOP_STR * 2);
    const int tid = otid(), wave = tid >> 6, lane = tid & 63, fr = lane & 15, fq = lane >> 4;
    for (int unit = obid(); unit < 512; unit += gridDim.x) {
        const int c = unit >> 2, h = unit & 3, r0 = c * 64;
        for (int i = tid; i < 64 * 40; i += NTHREADS) {
            const int t = i / 40, ch = i - t * 40;
            u32x4 v;
            if (ch < 8) v = *(const u32x4*)(GA + ((size_t)unit * 64 + t) * 64 + ch * 8);
            else if (ch < 24) v = *(const u32x4*)(GQ + (size_t)(r0 + t) * 512 + h * 128 + (ch - 8) * 8);
            else v = *(const u32x4*)(GQ + (size_t)(MTOK + r0 + t) * 512 + h * 128 + (ch - 24) * 8);
            *(u32x4*)(aop + t * AOP_STR + ch * 8) = v;
        }
        __syncthreads();
        f32x4 acc[2][4];
#pragma unroll
        for (int a = 0; a < 2; ++a)
#pragma unroll
            for (int b = 0; b < 4; ++b) acc[a][b] = (f32x4){0, 0, 0, 0};
#pragma unroll
        for (int ks = 0; ks < 10; ++ks) {
            bf16x8 ef[2];
#pragma unroll
            for (int a = 0; a < 2; ++a) {
                const int e = (wave * 2 + a) * 16 + fr;
                const bf16_t* src;
                if (ks < 2) src = GVT + ((size_t)unit * 256 + e) * 64 + ks * 32 + fq * 8;
                else if (ks < 6) src = GU + ((size_t)(unit * 2 + 0) * 256 + e) * 128 + (ks - 2) * 32 + fq * 8;
                else src = GU + ((size_t)(unit * 2 + 1) * 256 + e) * 128 + (ks - 6) * 32 + fq * 8;
                ef[a] = *(const bf16x8*)src;
            }
#pragma unroll
            for (int b = 0; b < 4; ++b) {
                const bf16x8 tf = *(const bf16x8*)(aop + (b * 16 + fr) * AOP_STR + ks * 32 + fq * 8);
#pragma unroll
                for (int a = 0; a < 2; ++a) acc[a][b] = __builtin_amdgcn_mfma_f32_16x16x32_bf16(ef[a], tf, acc[a][b], 0, 0, 0);
            }
        }
#pragma unroll
        for (int b = 0; b < 4; ++b) {
            float ss = 0.f;
#pragma unroll
            for (int a = 0; a < 2; ++a) ss += (acc[a][b].x * acc[a][b].x + acc[a][b].y * acc[a][b].y) + (acc[a][b].z * acc[a][b].z + acc[a][b].w * acc[a][b].w);
            ss += __shfl_xor(ss, 16); ss += __shfl_xor(ss, 32);
            if (fq == 0) red[wave * 64 + b * 16 + fr] = ss;
        }
        __syncthreads();
#pragma unroll
        for (int b = 0; b < 4; ++b) {
            const int t = b * 16 + fr;
            float tot = 0.f;
#pragma unroll
            for (int w = 0; w < 8; ++w) tot += red[w * 64 + t];
            const float rstd = rsqrtf(tot * (1.f / 256.f) + 1e-6f);
#pragma unroll
            for (int a = 0; a < 2; ++a) {
                const int e0 = (wave * 2 + a) * 16 + fq * 4;
                const u32x2 ogv = *(const u32x2*)(BIGb + (size_t)(r0 + t) * GLD + 2048 + h * 256 + e0);
                const f32x4 g = *(const f32x4*)(ng + e0);
                const float o0 = acc[a][b].x * rstd * g.x * silu_f(bflo(ogv.x));
                const float o1 = acc[a][b].y * rstd * g.y * silu_f(bfhi(ogv.x));
                const float o2 = acc[a][b].z * rstd * g.z * silu_f(bflo(ogv.y));
                const float o3 = acc[a][b].w * rstd * g.w * silu_f(bfhi(ogv.y));
                u32x2 w; w.x = pk2(o0, o1); w.y = pk2(o2, o3);
                *(u32x2*)(Z + (size_t)(r0 + t) * D + h * 256 + e0) = w;
            }
        }
        __syncthreads();
    }
}

#define XB_TMO      128
#define XB_XCNT(j)  (256  + 64 * (j))
#define XB_XSUB(j)  (1280 + 64 * (j))
#define XB_XGEN(j)  (2304 + 64 * (j))
#define XB_TOP      3328
#define XB_TOPGEN   3392
#define XCD_BAR_WORDS 3456
#define XB_SPIN_CAP (1u << 18)
#define XLAS __attribute__((address_space(3)))

__device__ __forceinline__ unsigned xb_ld(unsigned* p)              { return __hip_atomic_load(p, __ATOMIC_RELAXED, __HIP_MEMORY_SCOPE_AGENT); }
__device__ __forceinline__ unsigned xb_add(unsigned* p, unsigned v) { return __hip_atomic_fetch_add(p, v, __ATOMIC_RELAXED, __HIP_MEMORY_SCOPE_AGENT); }
__device__ __forceinline__ unsigned xb_xcc_id() { return (unsigned)__builtin_amdgcn_s_getreg((3 << 11) | 20) & 0xFu; }
#define XB_SPIN(cond, bar) do { unsigned _sp = 0; while (cond) { __builtin_amdgcn_s_sleep(1); \
    if ((++_sp & 255u) == 0u) { if (xb_ld(&(bar)[XB_TMO])) break; if (_sp > XB_SPIN_CAP) { atomicAdd(&(bar)[XB_TMO], 1u); break; } } } } while (0)

struct XcdBarrier {
    unsigned* bar; unsigned x;
    volatile XLAS unsigned* st;
};

__device__ __forceinline__ XcdBarrier xcd_barrier_post(unsigned* bar, volatile XLAS unsigned* st) {
    XcdBarrier b; b.bar = bar; b.x = xb_xcc_id(); b.st = st;
    if (threadIdx.x == 0) (void)xb_add(&bar[XB_XCNT(b.x)], 1u);
    return b;
}
__device__ __forceinline__ void xcd_barrier_complete(unsigned* bar, unsigned x, unsigned& nloc, unsigned& nx) {
    const unsigned G = gridDim.x * gridDim.y * gridDim.z;
    unsigned sum, cnt, mine, sp = 0u;
    for (;;) {
        sum = 0u; cnt = 0u; mine = 0u;
#pragma unroll
        for (unsigned j = 0; j < 16; ++j) { const unsigned c = xb_ld(&bar[XB_XCNT(j)]); sum += c; cnt += (c > 0u) ? 1u : 0u; mine = (j == x) ? c : mine; }
        if (sum == G) break;
        __builtin_amdgcn_s_sleep(1);
        if ((++sp & 255u) == 0u) { if (xb_ld(&bar[XB_TMO])) break; if (sp > XB_SPIN_CAP) { atomicAdd(&bar[XB_TMO], 1u); break; } }
    }
    nloc = mine > 0u ? mine : 1u; nx = cnt > 0u ? cnt : 1u;
}

__device__ __forceinline__ void xcd_barrier(const XcdBarrier& b) {
    asm volatile("s_waitcnt vmcnt(0)" ::: "memory");
    __syncthreads();
    if (threadIdx.x == 0) {
        unsigned* bar = b.bar;
        __builtin_amdgcn_s_waitcnt(0);
        unsigned nloc = b.st[0], nx = b.st[1];
        if (nloc == 0u) { xcd_barrier_complete(bar, b.x, nloc, nx); b.st[0] = nloc; b.st[1] = nx; }
        const unsigned old = xb_add(&bar[XB_XSUB(b.x)], 1u);
        const unsigned gen = old / nloc;
        if (old + 1u == (gen + 1u) * nloc) {
            __builtin_amdgcn_fence(__ATOMIC_RELEASE, "agent");
            asm volatile("s_waitcnt vmcnt(0)" ::: "memory");
            const unsigned og = xb_add(&bar[XB_TOP], 1u);
            const unsigned tg = og / nx;
            if (og + 1u == (tg + 1u) * nx) xb_add(&bar[XB_TOPGEN], 1u);
            else XB_SPIN(xb_ld(&bar[XB_TOPGEN]) == tg, bar);
            __builtin_amdgcn_fence(__ATOMIC_ACQUIRE, "agent");
            xb_add(&bar[XB_XGEN(b.x)], 1u);
            asm volatile("s_waitcnt vmcnt(0)" ::: "memory");
        } else {
            XB_SPIN(xb_ld(&bar[XB_XGEN(b.x)]) == gen, bar);
            __builtin_amdgcn_fence(__ATOMIC_ACQUIRE, "agent");
            asm volatile("s_waitcnt vmcnt(0)" ::: "memory");
        }
    }
    __syncthreads();
}

template <class Epi>
DEVI void run_gemm(unsigned char* smem, const bf16_t* A, const bf16_t* Bt, int N, int K, const Epi& E) {
    pg8::Gemm g{A, Bt, MTOK, N, K};
    pg8::StaticOrder S; S.init(MTOK, N, (int)gridDim.x, obid());
    pg8::gemm_phase<Epi, pg8::StaticOrder, true, true>((PG8_LAS unsigned char*)smem, g, S, E);
}

__global__ void __launch_bounds__(NTHREADS) mega_fwd(Params p) {
    extern __shared__ __attribute__((aligned(16))) unsigned char smem[];
    volatile XLAS unsigned* xst = (volatile XLAS unsigned*)(XLAS unsigned char*)(smem + LDS_PHASE);
    if (threadIdx.x == 0) { xst[0] = 0u; xst[1] = 0u; xst[2] = 0u; xst[3] = 0u; }
    __syncthreads();
    (void)xcd_barrier_post((unsigned*)(p.ws + WS_BAR), xst);
    if (p.ws == nullptr) cg::this_grid().sync();
#define GSYNC() do { XcdBarrier xb_; xb_.bar = (unsigned*)(p.ws + WS_BAR); xb_.x = xb_xcc_id(); xb_.st = (volatile XLAS unsigned*)(XLAS unsigned char*)(smem + LDS_PHASE); xcd_barrier(xb_); } while (0)

    phase_prep0(p, smem);
    GSYNC();
    phase_modfinal(p);
    GSYNC();
    phase_rows<0>(p, nullptr, nullptr, (const float*)(p.ws + WS_MOD), 0, 1, false);
    GSYNC();
#ifndef DBG_LAYERS
#define DBG_LAYERS 4
#endif
#pragma unroll 1
    for (int l = 0; l < DBG_LAYERS; ++l) {
        const int kind = l % 3, j = l / 3;
        {
            const bf16_t* Win; int Nin;
            if (kind == 0) { Win = (const bf16_t*)(p.ws + WS_WCIN) + (size_t)j * 3072 * 1024; Nin = 3072; }
            else if (kind == 1) { Win = (const bf16_t*)(p.ws + WS_WQKV); Nin = 1536; }
            else { Win = (const bf16_t*)(p.ws + WS_WGIN); Nin = 3328; }
            pg8::EpiStore E{(bf16_t*)(p.ws + WS_BIG), Nin};
            run_gemm(smem, (const bf16_t*)(p.ws + WS_H), Win, Nin, 1024, E);
        }
        GSYNC();
        if (kind == 0) { phase_conv(p, j); }
        else if (kind == 1) { phase_attn_prep(p, smem); GSYNC(); phase_attn(p, smem); }
        else { phase_gla_a(p, smem); GSYNC(); phase_gla_scan(p); GSYNC(); phase_gla_c(p, smem); }
        GSYNC();
        {
            const bf16_t* Wout;
            if (kind == 0) Wout = (const bf16_t*)(p.ws + WS_WCOUT) + (size_t)j * 1024 * 1024;
            else if (kind == 1) Wout = (const bf16_t*)(p.ws + WS_WAO);
            else Wout = (const bf16_t*)(p.ws + WS_WGO);
            pg8::EpiResid E{(float*)(p.ws + WS_X), (const float*)(p.ws + WS_MOD) + (size_t)l * 3 * 6144 + 2 * 1024};
            run_gemm(smem, (const bf16_t*)(p.ws + WS_Z), Wout, 1024, 1024, E);
        }
        GSYNC();
        phase_rows<1>(p, inp(10) + (size_t)(l * 2 + 0) * D, inp(11) + (size_t)(l * 2 + 0) * D, (const float*)(p.ws + WS_MOD) + (size_t)l * 3 * 6144, 3, 4, false);
        GSYNC();
        {
            pg8::EpiSwiglu E{(bf16_t*)(p.ws + WS_BIG), DFF};
            run_gemm(smem, (const bf16_t*)(p.ws + WS_H), (const bf16_t*)(p.ws + WS_WFIN) + (size_t)l * 5632 * 1024, 5632, 1024, E);
        }
        GSYNC();
        {
            pg8::EpiResid E{(float*)(p.ws + WS_X), (const float*)(p.ws + WS_MOD) + (size_t)l * 3 * 6144 + 5 * 1024};
            run_gemm(smem, (const bf16_t*)(p.ws + WS_BIG), (const bf16_t*)(p.ws + WS_WFOUT) + (size_t)l * 1024 * 2816, 1024, 2816, E);
            if (l < 3 && obid() >= 128 && (int)gridDim.x > 128) prep_layer(p, l + 1, obid() - 128, (int)gridDim.x - 128, smem);
        }
        GSYNC();
        phase_rows<1>(p, inp(10) + (size_t)(l * 2 + 1) * D, inp(11) + (size_t)(l * 2 + 1) * D,
                      l < 3 ? (const float*)(p.ws + WS_MOD) + (size_t)(l + 1) * 3 * 6144 : nullptr, 0, 1, l == DBG_LAYERS - 1);
        GSYNC();
    }
}

extern "C" void kernel_launch(void* const* d_in, const int* in_sizes, int n_in, void* d_out, int out_size, void* d_ws, size_t ws_size, hipStream_t stream) {
    static int grid_blocks = 0;
    if (grid_blocks == 0) {
        if (n_in != 27 || ws_size < WS_TOTAL) { fprintf(stderr, "kernel_launch: unexpected n_in %d or ws_size %zu (< %zu)\n", n_in, ws_size, (size_t)WS_TOTAL); grid_blocks = -1; return; }
        int dev = 0, cus = 0, per_cu = 0;
        hipGetDevice(&dev);
        hipDeviceGetAttribute(&cus, hipDeviceAttributeMultiprocessorCount, dev);
        hipFuncSetAttribute((const void*)mega_fwd, hipFuncAttributeMaxDynamicSharedMemorySize, LDS_BYTES);
        hipOccupancyMaxActiveBlocksPerMultiprocessor(&per_cu, (const void*)mega_fwd, NTHREADS, LDS_BYTES);
        if (per_cu < 1) per_cu = 1;
        grid_blocks = cus * 1;
        (void)hipGetLastError();
    }
    if (grid_blocks < 0) return;
    if (hipMemsetAsync((char*)d_ws + WS_BAR, 0, 16384, stream) != hipSuccess) { fprintf(stderr, "kernel_launch: memset of barrier words failed\n"); return; }
    Params p{};
    for (int i = 0; i < 27; ++i) p.in[i] = (const float*)d_in[i];
    p.out = (float*)d_out; p.ws = (unsigned char*)d_ws;
    void* args[] = {&p};
    hipError_t e = hipLaunchCooperativeKernel((const void*)mega_fwd, dim3(grid_blocks), dim3(NTHREADS), args, LDS_BYTES, stream);
    if (e != hipSuccess) fprintf(stderr, "cooperative launch failed: %s (grid %d)\n", hipGetErrorString(e), grid_blocks);
}
#ifdef PHASE_TEST
__global__ void __launch_bounds__(NTHREADS) t_gemm0(Params p, int N) { extern __shared__ __attribute__((aligned(16))) unsigned char smem[]; pg8::EpiStore E{(bf16_t*)(p.ws + WS_BIG), N}; run_gemm(smem, (const bf16_t*)(p.ws + WS_H), (const bf16_t*)(p.ws + WS_WCIN), N, 1024, E); }
__global__ void __launch_bounds__(NTHREADS) t_gemm1(Params p) { extern __shared__ __attribute__((aligned(16))) unsigned char smem[]; pg8::EpiSwiglu E{(bf16_t*)(p.ws + WS_BIG), DFF}; run_gemm(smem, (const bf16_t*)(p.ws + WS_H), (const bf16_t*)(p.ws + WS_WFIN), 5632, 1024, E); }
__global__ void __launch_bounds__(NTHREADS) t_gemm2(Params p, int K) { extern __shared__ __attribute__((aligned(16))) unsigned char smem[]; pg8::EpiResid E{(float*)(p.ws + WS_X), (const float*)(p.ws + WS_MOD)}; run_gemm(smem, (const bf16_t*)(p.ws + WS_Z), (const bf16_t*)(p.ws + WS_WCOUT), 1024, K, E); }
#endif
```
